# Optimizing an MI355X kernel written in HIP

```python
import math
import jax, jax.numpy as jnp
from jax import lax
import numpy as np

D_MODEL = 1024
BATCH = 2
SEQ = 16384
DEPTH = 2

PLE_DIM = 256
HEAD_DIM = 64
DIFF_HEADS = 8
DIFF_QK = DIFF_HEADS * 2 * HEAD_DIM
DIFF_V = DIFF_HEADS * 2 * HEAD_DIM
SWA_HEADS = 16
SWA_KV_HEADS = 2
SWA_GROUP = SWA_HEADS // SWA_KV_HEADS
SWA_Q = SWA_HEADS * HEAD_DIM
SWA_KV = SWA_KV_HEADS * HEAD_DIM
WINDOW = 128
Q_BLOCK = 128
IN_SPLITS = (DIFF_QK, DIFF_QK, DIFF_V, SWA_Q, SWA_KV, SWA_KV, D_MODEL, D_MODEL)
IN_WIDTH = sum(IN_SPLITS)
N_EXPERTS = 32
TOP_K = 4
D_FF = D_MODEL
SWIGLU_LIMIT = 7.0
SWIGLU_ALPHA = 1.702
MOE_BLOCK = 512
LN_EPS = 1e-5
RMS_EPS = 1e-5
DN_ALPHA = (2 * DEPTH) ** 0.25
DN_BETA = (8 * DEPTH) ** -0.25

kernel_name = "hybrid_diffattn_swa_sinks_moe_deepnorm"


def layer_norm(x, g, b):
    xf = x.astype(jnp.float32)
    mu = jnp.mean(xf, axis=-1, keepdims=True)
    var = jnp.mean(jnp.square(xf - mu), axis=-1, keepdims=True)
    y = (xf - mu) * lax.rsqrt(var + LN_EPS)
    return (y * g.astype(jnp.float32) + b.astype(jnp.float32)).astype(x.dtype)


def rms_norm(x, w):
    xf = x.astype(jnp.float32)
    y = xf * lax.rsqrt(jnp.mean(jnp.square(xf), axis=-1, keepdims=True) + RMS_EPS)
    return (y * w.astype(jnp.float32)).astype(x.dtype)


def alibi_slopes(n_heads):
    h = jnp.arange(1, n_heads + 1, dtype=jnp.float32)
    return jnp.exp2(-8.0 * h / n_heads)


def split_in(proj):
    idx, acc = [], 0
    for w in IN_SPLITS[:-1]:
        acc += w
        idx.append(acc)
    return jnp.split(proj, idx, axis=-1)


def diff_attention(q, k, v, lam, subln_w, lam_init):
    B, S = q.shape[0], q.shape[1]
    nb = S // Q_BLOCK
    scale = HEAD_DIM ** -0.5
    slopes = alibi_slopes(DIFF_HEADS)
    q_blocks = jnp.moveaxis(q.reshape(B, nb, Q_BLOCK, DIFF_HEADS, 2, HEAD_DIM), 1, 0)
    key_pos = jnp.arange(S)

    def one_block(args):
        qb, n = args
        s = jnp.einsum('bqhcd,bkhcd->bhcqk', qb, k).astype(jnp.float32) * scale
        dist = (n * Q_BLOCK + jnp.arange(Q_BLOCK))[:, None] - key_pos[None, :]
        s = s - slopes[None, :, None, None, None] * jnp.abs(dist).astype(jnp.float32)
        s = jnp.where(dist >= 0, s, -jnp.inf)
        prob = jax.nn.softmax(s, axis=-1)
        a = (prob[:, :, 0] - lam * prob[:, :, 1]).astype(v.dtype)
        return jnp.einsum('bhqk,bkhe->bqhe', a, v)

    o = lax.map(one_block, (q_blocks, jnp.arange(nb)))
    o = jnp.moveaxis(o, 0, 1).reshape(B, S, DIFF_HEADS, 2 * HEAD_DIM)
    o = rms_norm(o, subln_w) * (1.0 - lam_init)
    return o.reshape(B, S, DIFF_V)


def swa_attention(q, k, v, sinks):
    B, S = q.shape[0], q.shape[1]
    nb = S // Q_BLOCK
    scale = HEAD_DIM ** -0.5

    def blocks(t):
        return t.reshape((B, nb, Q_BLOCK) + t.shape[2:])

    def with_prev(t):
        prev = jnp.concatenate([jnp.zeros_like(t[:, :1]), t[:, :-1]], axis=1)
        return jnp.concatenate([prev, t], axis=2)

    qb = blocks(q)
    kb = with_prev(blocks(k))
    vb = with_prev(blocks(v))
    s = jnp.einsum('bnqhgd,bnkhd->bnhgqk', qb, kb).astype(jnp.float32) * scale
    kj = jnp.arange(2 * Q_BLOCK)
    dist = (jnp.arange(Q_BLOCK) + Q_BLOCK)[:, None] - kj[None, :]
    key_pos = jnp.arange(nb)[:, None] * Q_BLOCK - Q_BLOCK + kj[None, :]
    valid = (dist >= 0)[None] & (dist < WINDOW)[None] & (key_pos >= 0)[:, None, :]
    slopes = alibi_slopes(SWA_HEADS).reshape(SWA_KV_HEADS, SWA_GROUP)
    s = s - slopes[:, :, None, None] * jnp.abs(dist).astype(jnp.float32)
    s = jnp.where(valid[None, :, None, None], s, -jnp.inf)
    sink = sinks.astype(jnp.float32).reshape(SWA_KV_HEADS, SWA_GROUP)[:, :, None, None]
    m = jnp.maximum(jnp.max(s, axis=-1, keepdims=True), sink)
    e = jnp.exp(s - m)
    denom = jnp.sum(e, axis=-1, keepdims=True) + jnp.exp(sink - m)
    prob = (e / denom).astype(v.dtype)
    o = jnp.einsum('bnhgqk,bnkhd->bnqhgd', prob, vb)
    return o.reshape(B, S, SWA_Q)


def moe(h, w_router, b_router, w_gu, b_gu, w_down, b_down):
    B, S, D = h.shape
    N = B * S
    hf = h.reshape(N, D)
    logits = (hf @ w_router + b_router).astype(jnp.float32)
    top_logits, top_idx = lax.top_k(logits, TOP_K)
    gates = jax.nn.softmax(top_logits, axis=-1)
    A = N * TOP_K
    n_blocks = A // MOE_BLOCK + N_EXPERTS + 1
    flat_e = top_idx.reshape(A)
    order = jnp.argsort(flat_e)
    sorted_e = flat_e[order]
    counts = jnp.bincount(flat_e, length=N_EXPERTS)
    padded = (counts + MOE_BLOCK - 1) // MOE_BLOCK * MOE_BLOCK
    padded_end = jnp.cumsum(padded)
    rank = jnp.arange(A) - (jnp.cumsum(counts) - counts)[sorted_e]
    dest = (padded_end - padded)[sorted_e] + rank
    n_slots = n_blocks * MOE_BLOCK
    slot_tok = jnp.full((n_slots,), N, jnp.int32).at[dest].set((order // TOP_K).astype(jnp.int32))
    slot_gate = jnp.zeros((n_slots,), jnp.float32).at[dest].set(gates.reshape(A)[order])
    block_e = jnp.minimum(
        jnp.searchsorted(padded_end, jnp.arange(n_blocks) * MOE_BLOCK, side='right'),
        N_EXPERTS - 1)
    hf_pad = jnp.concatenate([hf, jnp.zeros((1, D), hf.dtype)], axis=0)

    def expert_block(args):
        tok, g, e = args
        xb = hf_pad[tok]
        gu = xb @ w_gu[e] + b_gu[e]
        gate, up = jnp.split(gu, 2, axis=-1)
        gate = jnp.minimum(gate, SWIGLU_LIMIT)
        up = jnp.clip(up, -SWIGLU_LIMIT, SWIGLU_LIMIT)
        act = (up + 1.0) * (gate * jax.nn.sigmoid(SWIGLU_ALPHA * gate))
        y = act @ w_down[e] + b_down[e]
        return y * g[:, None].astype(y.dtype)

    y = lax.map(expert_block, (slot_tok.reshape(n_blocks, MOE_BLOCK),
                               slot_gate.reshape(n_blocks, MOE_BLOCK), block_e))
    out = jnp.zeros((N + 1, D), y.dtype).at[slot_tok].add(y.reshape(n_slots, D))
    return out[:N].reshape(B, S, D)


def setup_inputs(seed: int = 0) -> dict:
    key = jax.random.key(seed)
    ks = jax.random.split(key, 26)
    f32 = jnp.float32

    def nrm(k, shape, scale):
        return jax.random.normal(k, shape, f32) * scale

    col_scale = jnp.concatenate([
        jnp.ones((2 * DIFF_QK,), f32), jnp.full((DIFF_V,), DN_BETA, f32),
        jnp.ones((SWA_Q + SWA_KV,), f32), jnp.full((SWA_KV,), DN_BETA, f32),
        jnp.ones((2 * D_MODEL,), f32)])
    return {
        "x": nrm(ks[0], (BATCH, SEQ, D_MODEL), 1.0),
        "p": nrm(ks[1], (DEPTH, BATCH, SEQ, PLE_DIM), 1.0),
        "w_in": nrm(ks[2], (DEPTH, D_MODEL, IN_WIDTH), D_MODEL ** -0.5) * col_scale,
        "b_in": nrm(ks[3], (DEPTH, IN_WIDTH), 0.01),
        "lambda_q1": nrm(ks[4], (DEPTH, HEAD_DIM), 0.1),
        "lambda_k1": nrm(ks[5], (DEPTH, HEAD_DIM), 0.1),
        "lambda_q2": nrm(ks[6], (DEPTH, HEAD_DIM), 0.1),
        "lambda_k2": nrm(ks[7], (DEPTH, HEAD_DIM), 0.1),
        "subln_w": 1.0 + nrm(ks[8], (DEPTH, 2 * HEAD_DIM), 0.01),
        "sinks": nrm(ks[9], (DEPTH, SWA_HEADS), 0.5),
        "w_br_diff": nrm(ks[10], (DEPTH, DIFF_V, D_MODEL), DIFF_V ** -0.5),
        "w_br_swa": nrm(ks[11], (DEPTH, SWA_Q, D_MODEL), SWA_Q ** -0.5),
        "w_out": nrm(ks[12], (DEPTH, D_MODEL, D_MODEL), D_MODEL ** -0.5 * DN_BETA),
        "b_out": nrm(ks[13], (DEPTH, D_MODEL), 0.01),
        "ln1_g": 1.0 + nrm(ks[14], (DEPTH, D_MODEL), 0.01),
        "ln1_b": nrm(ks[15], (DEPTH, D_MODEL), 0.01),
        "w_router": nrm(ks[16], (DEPTH, D_MODEL, N_EXPERTS), D_MODEL ** -0.5),
        "b_router": nrm(ks[17], (DEPTH, N_EXPERTS), 0.01),
        "w_gate_up": nrm(ks[18], (DEPTH, N_EXPERTS, D_MODEL, 2 * D_FF), D_MODEL ** -0.5),
        "b_gate_up": nrm(ks[19], (DEPTH, N_EXPERTS, 2 * D_FF), 0.01),
        "w_down": nrm(ks[20], (DEPTH, N_EXPERTS, D_FF, D_MODEL), D_FF ** -0.5 * DN_BETA),
        "b_down": nrm(ks[21], (DEPTH, N_EXPERTS, D_MODEL), 0.01),
        "w_ple_gate": nrm(ks[22], (DEPTH, D_MODEL, D_MODEL), D_MODEL ** -0.5),
        "w_ple_proj": nrm(ks[23], (DEPTH, PLE_DIM, D_MODEL), PLE_DIM ** -0.5 * DN_BETA),
        "ln2_g": 1.0 + nrm(ks[24], (DEPTH, D_MODEL), 0.01),
        "ln2_b": nrm(ks[25], (DEPTH, D_MODEL), 0.01),
    }


def reference(x, p, w_in, b_in, lambda_q1, lambda_k1, lambda_q2, lambda_k2, subln_w, sinks,
              w_br_diff, w_br_swa, w_out, b_out, ln1_g, ln1_b, w_router, b_router,
              w_gate_up, b_gate_up, w_down, b_down, w_ple_gate, w_ple_proj, ln2_g, ln2_b):
    B, S, _ = x.shape
    for i in range(DEPTH):
        lam_init = 0.8 - 0.6 * math.exp(-0.3 * i)
        proj = x @ w_in[i] + b_in[i]
        dq, dk, dv, sq, sk, sv, ga, gb = split_in(proj)
        lam = (jnp.exp(jnp.sum(lambda_q1[i].astype(jnp.float32) * lambda_k1[i].astype(jnp.float32)))
               - jnp.exp(jnp.sum(lambda_q2[i].astype(jnp.float32) * lambda_k2[i].astype(jnp.float32)))
               + lam_init)
        o_diff = diff_attention(dq.reshape(B, S, DIFF_HEADS, 2, HEAD_DIM),
                                dk.reshape(B, S, DIFF_HEADS, 2, HEAD_DIM),
                                dv.reshape(B, S, DIFF_HEADS, 2 * HEAD_DIM),
                                lam, subln_w[i], lam_init)
        o_swa = swa_attention(sq.reshape(B, S, SWA_KV_HEADS, SWA_GROUP, HEAD_DIM),
                              sk.reshape(B, S, SWA_KV_HEADS, HEAD_DIM),
                              sv.reshape(B, S, SWA_KV_HEADS, HEAD_DIM),
                              sinks[i])
        merged = (jax.nn.sigmoid(ga) * (o_diff @ w_br_diff[i])
                  + jax.nn.sigmoid(gb) * (o_swa @ w_br_swa[i]))
        mix = merged @ w_out[i] + b_out[i]
        x = layer_norm(DN_ALPHA * x + mix, ln1_g[i], ln1_b[i])
        ffn = moe(x, w_router[i], b_router[i], w_gate_up[i], b_gate_up[i], w_down[i], b_down[i])
        ple = jax.nn.sigmoid(x @ w_ple_gate[i]) * (p[i] @ w_ple_proj[i])
        x = layer_norm(DN_ALPHA * x + ffn + ple, ln2_g[i], ln2_b[i])
    return x
```

```cpp
#include <hip/hip_runtime.h>
#include <cstdio>
#include <cstdint>

#ifndef MK_N_LAUNCHES
#define MK_N_LAUNCHES 1
#endif

#define GAS __attribute__((address_space(1)))
#define LAS __attribute__((address_space(3)))
typedef unsigned short bf16_t;
typedef short bf16x8 __attribute__((ext_vector_type(8)));
typedef short s16x4 __attribute__((ext_vector_type(4)));
typedef float f32x4 __attribute__((ext_vector_type(4)));
typedef float f32x2 __attribute__((ext_vector_type(2)));
typedef float f32x16 __attribute__((ext_vector_type(16)));
typedef unsigned u32x4 __attribute__((ext_vector_type(4)));
typedef unsigned u32x2 __attribute__((ext_vector_type(2)));
typedef int i32x4 __attribute__((ext_vector_type(4)));

constexpr int NBATCH = 2, SEQ = 16384, NTOK = NBATCH * SEQ, DM = 1024, INW = 6400, NEXP = 32, TOPK = 4, PLED = 256, DEPTH = 2;
constexpr int COL_DQ = 0, COL_DK = 1024, COL_DV = 2048, COL_SQ = 3072, COL_SK = 4096, COL_SV = 4224, COL_GA = 4352, COL_GB = 5376;
constexpr float LOG2E = 1.4426950408889634f, QSCALE = 0.125f * LOG2E, DN_ALPHA = 1.4142135623730951f;
constexpr float LN_EPS = 1e-5f, RMS_EPS = 1e-5f;
constexpr int LIST_CAP = NTOK;
constexpr int SLOTS_MAX = 139264;

constexpr size_t MiB = 1u << 20;
constexpr size_t WS_CTL = 0, CTL_ZERO_BYTES = 1 * MiB;
constexpr size_t WS_WIN = 2 * MiB, WS_WA = 27 * MiB, WS_WB = 31 * MiB, WS_WOUT = 35 * MiB, WS_WPG = 39 * MiB, WS_WPP = 43 * MiB;
constexpr size_t WS_WGU = 44 * MiB, WS_WDN = 300 * MiB;
constexpr size_t WS_XB = 428 * MiB, WS_PB = 492 * MiB, WS_PROJ = 524 * MiB, WS_ACT = WS_PROJ  ;
constexpr size_t WS_WIN8 = (1244 + 66) * MiB;
constexpr size_t WS_XB8 = (1244 + 72) * MiB;
constexpr float WING_SC = 32.0f, XIN_SC = 16.0f, ATT_OSC = 16.0f, WAB_SC = 32.0f;
constexpr int NT_PROJ = 17, NT_GATE = 8;
constexpr size_t WS_WPG8 = (1244 + 64) * MiB;
constexpr float WPGSC = 32.0f;
constexpr size_t WS_OD = 924 * MiB, WS_OS = 988 * MiB, WS_MG = 1052 * MiB, WS_PRE = 1116 * MiB, WS_X1 = 1244 * MiB, WS_X1B = 1372 * MiB;
constexpr size_t WS_Y = 1436 * MiB, WS_TPP = 1708 * MiB, WS_LTOK = 1772 * MiB, WS_LGATE = 1776 * MiB, WS_TOKE = 1780 * MiB, WS_TOKP = 1781 * MiB, WS_KIMG = 1782 * MiB, WS_VIMG = 1846 * MiB, WS_X1F8 = 1910 * MiB, WS_END = 1942 * MiB;
static_assert((size_t)SLOTS_MAX * DM * 2 <= 272 * MiB, "act / y size");
constexpr int CW_TMO = 0, CW_CODE = 1, CW_BAR = 4096, CW_Q = 8192, CW_CNT = 12288, CW_KMAX = 20480, CW_QX = 24576, CW_BG = 32768;

constexpr int RING_OFF = 0, RING_BYTES = 131072;
constexpr int LDSCTL_OFF = RING_BYTES;
constexpr int LC_MISC = LDSCTL_OFF;
constexpr int LC_CNT = LDSCTL_OFF + 256;
constexpr int LC_OFFS = LDSCTL_OFF + 512;
constexpr int LC_MTS = LDSCTL_OFF + 768;
constexpr int LC_LCNT = LDSCTL_OFF + 1024;
constexpr int LC_LOG = LDSCTL_OFF + 1536;
constexpr int LC_ENT = LDSCTL_OFF + 2560;
constexpr int LC_WSF = LDSCTL_OFF + 8704;
constexpr int LC_TOKC = LDSCTL_OFF + 10752 + 64;
constexpr int LDS_BYTES = 163840;
static_assert(LC_TOKC + 20 * 256 * 4 <= LDS_BYTES, "LDS map");

#define RLX_AGENT __ATOMIC_RELAXED, __HIP_MEMORY_SCOPE_AGENT
#define LDS_WAIT() asm volatile("s_waitcnt lgkmcnt(0)" ::: "memory")
#define VM_WAIT() asm volatile("s_waitcnt vmcnt(0)" ::: "memory")

__device__ __forceinline__ unsigned cvt_pk_bf16(float lo, float hi) { unsigned r; asm volatile("v_cvt_pk_bf16_f32 %0, %1, %2" : "=v"(r) : "v"(lo), "v"(hi)); return r; }
__device__ __forceinline__ unsigned pk4_fp8(float a, float b, float c, float d) { int w = 0; w = __builtin_amdgcn_cvt_pk_fp8_f32(a, b, w, false); w = __builtin_amdgcn_cvt_pk_fp8_f32(c, d, w, true); return (unsigned)w; }
__device__ __forceinline__ float bf_lo(unsigned u) { return __uint_as_float(u << 16); }
__device__ __forceinline__ float bf_hi(unsigned u) { return __uint_as_float(u & 0xffff0000u); }
__device__ __forceinline__ float sigmoidf_(float x) { return __builtin_amdgcn_rcpf(1.0f + __builtin_amdgcn_exp2f(-x * LOG2E)); }
__device__ __forceinline__ float dpp_xor1(float v) { return __builtin_bit_cast(float, __builtin_amdgcn_update_dpp(0, __builtin_bit_cast(int, v), 0xB1, 0xf, 0xf, true)); }
__device__ __forceinline__ float dpp_xor2(float v) { return __builtin_bit_cast(float, __builtin_amdgcn_update_dpp(0, __builtin_bit_cast(int, v), 0x4E, 0xf, 0xf, true)); }
__device__ __forceinline__ float shx(float v, int m, int lane) { return __builtin_bit_cast(float, __builtin_amdgcn_ds_bpermute((lane ^ m) << 2, __builtin_bit_cast(int, v))); }
__device__ __forceinline__ float wave_sum(float v, int lane) {
#pragma unroll
    for (int o = 1; o < 64; o <<= 1) v += shx(v, o, lane);
    return v;
}

namespace pg8 {
#define PG8_LAS __attribute__((address_space(3)))
constexpr int BM = 256, BK = 64, HALF = 128, HTB = HALF * BK * 2, STAGE_BYTES = 8 * HTB, NXCD = 8, WGM = 8;
__host__ __device__ __forceinline__ int lds_byte(int r, int c) { const int st = (r >> 4) * 2 + (c >> 5), rr = r & 15, cc = c & 31, ob = rr * 64 + cc * 2; return st * 1024 + (ob ^ (((ob >> 9) & 1) << 5)); }
__host__ __device__ __forceinline__ void stage_rc(int b, int& R, int& C) { const int st = b / 1024, sb = b % 1024, swz = sb ^ (((sb >> 9) & 1) << 5); R = (st >> 1) * 16 + swz / 64; C = (st & 1) * 32 + (swz % 64) / 2; }
__host__ __device__ __forceinline__ int perm32(int rho) { const int n = rho >> 4, i = rho & 15; return 8 * (i >> 2) + 4 * n + (i & 3); }

struct Unit { int pm, pn, ex; };

struct DenseSched {
    static constexpr bool UNIT_OFFS = false; static constexpr int SCALE_A = 0x7F7F7F7F, SCALE_B = 0x7F7F7F7F;
    const char* A; const char* Bt; int K; int nM, nN, nwg, G, c;
    __device__ void init(const void* A_, const void* Bt_, int M, int N, int K_, int G_, int c_) { A = (const char*)A_; Bt = (const char*)Bt_; K = K_; nM = M / BM; nN = N / BM; nwg = nM * nN; G = G_; c = c_; }
    __device__ __forceinline__ bool next(int i, Unit& u) const {
        const long L = (long)i * G + c; if (L >= nwg) return false;
        int wgid = (int)L; { const int q = nwg / NXCD, r = nwg % NXCD, xcd = wgid % NXCD, off = wgid / NXCD; wgid = (xcd < r ? xcd * (q + 1) : r * (q + 1) + (xcd - r) * q) + off; }
        const int nig = WGM * nN, gid = wgid / nig, fm = gid * WGM, gsz = (nM - fm) < WGM ? (nM - fm) : WGM;
        u.pm = fm + ((wgid % nig) % gsz); u.pn = (wgid % nig) / gsz; u.ex = 0; return true;
    }
    __device__ __forceinline__ const char* a_base(const Unit& u) const { return A + (size_t)u.pm * BM * K * 2; }
    __device__ __forceinline__ void a_offs(const Unit&, const int (&R)[2], const int (&C)[2], unsigned (&off)[2][2]) const {
#pragma unroll
        for (int h = 0; h < 2; ++h)
#pragma unroll
            for (int i = 0; i < 2; ++i) off[h][i] = (unsigned)((h * HALF + R[i]) * K + C[i]) * 2u;
    }
    __device__ __forceinline__ const char* b_base(const Unit& u, int h) const { return Bt + ((size_t)u.pn * BM + h * HALF) * K * 2; }
};

struct DenseSchedF8 : DenseSched { static constexpr int SCALE_A = 0x7D7D7D7D, SCALE_B = 0x7A7A7A7A; };
struct DenseSchedF8in : DenseSched { static constexpr int SCALE_A = 0x7B7B7B7B, SCALE_B = 0x7A7A7A7A;
    int nl = 0, cntL = 0, cntS = 0;
    __device__ __forceinline__ bool next(int i, Unit& u) const {
        if (nl == 0) return DenseSched::next(i, u);
        int L; if (c < nl) { if (i >= cntL) return false; L = i * nl + c; } else { if (i >= cntS) return false; L = nl * cntL + i * (G - nl) + (c - nl); }
        int wgid = L; { const int q = nwg / NXCD, r = nwg % NXCD, xcd = wgid % NXCD, off = wgid / NXCD; wgid = (xcd < r ? xcd * (q + 1) : r * (q + 1) + (xcd - r) * q) + off; }
        const int nig = WGM * nN, gid = wgid / nig, fm = gid * WGM, gsz = (nM - fm) < WGM ? (nM - fm) : WGM;
        u.pm = fm + ((wgid % nig) % gsz); u.pn = (wgid % nig) / gsz; u.ex = 0; return true;
    }
};
template <class Epi, class Sched, bool ALIGN_EPI = true, bool FP8 = false>
__device__ __forceinline__ void gemm_phase(PG8_LAS unsigned char* lds, const int K, const Sched& S, const Epi& E, const int tid  ) {
    const int wid = __builtin_amdgcn_readfirstlane(tid >> 6), lane = tid & 63, wr = wid >> 2, wc = wid & 3, fr = lane & 15, fq = lane >> 4;
    const int nt = K / BK;
    int R[2], C[2]; unsigned voffB[2];
#pragma unroll
    for (int i = 0; i < 2; ++i) { stage_rc(tid * 16 + i * 8192, R[i], C[i]); const int Rb = Epi::PERM ? ((R[i] & ~31) + perm32(R[i] & 31)) : R[i]; voffB[i] = (unsigned)(Rb * K + C[i]) * 2u; }
    const unsigned kstep = (unsigned)(BK * 2);
    const unsigned ldsw = (unsigned)wid * 1024u;
    const int aoff = lds_byte(wr * 64 + fr, fq * 8), boff = lds_byte(wc * 32 + fr, fq * 8);
#define PG8_SA(b, h) (((b) * 2 + (h)) * HTB)
#define PG8_SB(b, h) ((4 + (b) * 2 + (h)) * HTB)
#define PG8_GLDS(sbase_, voff_, ldsdst_) do { unsigned keep_; asm volatile("s_mov_b32 %0, m0\n\ts_mov_b32 m0, %3\n\ts_nop 0\n\tglobal_load_lds_dwordx4 %1, %2\n\ts_mov_b32 m0, %0" \
        : "=&s"(keep_) : "v"(voff_), "s"(sbase_), "s"(ldsdst_) : "memory"); } while (0)
    const unsigned ldsbase = (unsigned)(uintptr_t)lds + ldsw;
#define PG8_STAGE_A(bufoff, h, base, offs, kb) do { const char* _b = (base) + (kb); _Pragma("unroll") for (int _i = 0; _i < 2; ++_i) \
        PG8_GLDS(_b, (offs)[h][_i], (unsigned)__builtin_amdgcn_readfirstlane(ldsbase + (bufoff) + _i * 8192)); } while (0)
#define PG8_STAGE_B(bufoff, base, kb) do { const char* _b = (base) + (kb); _Pragma("unroll") for (int _i = 0; _i < 2; ++_i) \
        PG8_GLDS(_b, voffB[_i], (unsigned)__builtin_amdgcn_readfirstlane(ldsbase + (bufoff) + _i * 8192)); } while (0)
#define PG8_LDA(dst, b, h) do { _Pragma("unroll") for (int m = 0; m < 4; ++m) _Pragma("unroll") for (int k = 0; k < 2; ++k) dst[m][k] = *(const PG8_LAS bf16x8*)(lds + PG8_SA(b, h) + aoff + m * 2048 + k * 1024); } while (0)
#define PG8_LDB(dst, b, h) do { _Pragma("unroll") for (int n = 0; n < 2; ++n) _Pragma("unroll") for (int k = 0; k < 2; ++k) dst[n][k] = *(const PG8_LAS bf16x8*)(lds + PG8_SB(b, h) + boff + n * 2048 + k * 1024); } while (0)
#define PG8_MMA(ai, bj, At, Bt) do { __builtin_amdgcn_s_setprio(1); _Pragma("unroll") for (int m = 0; m < 4; ++m) _Pragma("unroll") for (int n = 0; n < 2; ++n) { \
        if constexpr (FP8) { acc[ai][bj][m][n] = __builtin_amdgcn_mfma_scale_f32_16x16x128_f8f6f4(__builtin_shufflevector(__builtin_bit_cast(i32x4, Bt[n][0]), __builtin_bit_cast(i32x4, Bt[n][1]), 0, 1, 2, 3, 4, 5, 6, 7), \
                __builtin_shufflevector(__builtin_bit_cast(i32x4, At[m][0]), __builtin_bit_cast(i32x4, At[m][1]), 0, 1, 2, 3, 4, 5, 6, 7), acc[ai][bj][m][n], 0, 0, 0, Sched::SCALE_B, 0, Sched::SCALE_A); } \
        else { _Pragma("unroll") for (int k = 0; k < 2; ++k) acc[ai][bj][m][n] = __builtin_amdgcn_mfma_f32_16x16x32_bf16(Bt[n][k], At[m][k], acc[ai][bj][m][n], 0, 0, 0); } } \
        __builtin_amdgcn_s_setprio(0); } while (0)
#define PG8_WAIT_V(n) asm volatile("s_waitcnt vmcnt(" #n ")" ::: "memory")
#define PG8_WAIT_L(n) asm volatile("s_waitcnt lgkmcnt(" #n ")" ::: "memory")
#define PG8_BAR __builtin_amdgcn_s_barrier()
#define PG8_SCHED __builtin_amdgcn_sched_barrier(0)
    Unit cur, nxt; int ui = 0;
    if (!S.next(0, cur)) return;
    f32x4 acc[2][2][4][2];
#pragma unroll
    for (int a = 0; a < 2; ++a)
#pragma unroll
        for (int b = 0; b < 2; ++b)
#pragma unroll
            for (int m = 0; m < 4; ++m)
#pragma unroll
                for (int n = 0; n < 2; ++n) acc[a][b][m][n] = (f32x4){0.f, 0.f, 0.f, 0.f};
    bf16x8 At[4][2], B0[2][2], B1[2][2];
    unsigned coff[2][2];
    S.a_offs(cur, R, C, coff);
    const char* cA = S.a_base(cur); const char* cB0 = S.b_base(cur, 0); const char* cB1 = S.b_base(cur, 1);
    PG8_STAGE_B(PG8_SB(0, 0), cB0, 0u); PG8_STAGE_B(PG8_SB(0, 1), cB1, 0u); PG8_STAGE_A(PG8_SA(0, 0), 0, cA, coff, 0u); PG8_STAGE_A(PG8_SA(0, 1), 1, cA, coff, 0u);
    if (wr == 1) PG8_BAR;
    PG8_WAIT_V(2); PG8_BAR;
    PG8_STAGE_B(PG8_SB(1, 0), cB0, kstep); PG8_STAGE_A(PG8_SA(1, 0), 0, cA, coff, kstep); PG8_STAGE_B(PG8_SB(1, 1), cB1, kstep);
    PG8_WAIT_V(6); PG8_BAR;
    for (;;) {
        const bool has_next = S.next(ui + 1, nxt);
        const char* nA = cA; const char* nB0 = cB0; const char* nB1 = cB1;
        if (has_next) { nA = S.a_base(nxt); nB0 = S.b_base(nxt, 0); nB1 = S.b_base(nxt, 1); }
#pragma unroll 1
        for (int t = 0; t < nt; t += 2) {
            const bool last = (t == nt - 2);
            const unsigned a1k = (unsigned)(t + 1) * kstep;
            const char* a2 = last ? nA : cA; const char* b20 = last ? nB0 : cB0; const char* b21 = last ? nB1 : cB1;
            const unsigned a2k = last ? 0u : (unsigned)(t + 2) * kstep, a3k = a2k + kstep;
            PG8_LDB(B0, 0, 0); PG8_LDB(B1, 0, 1); PG8_SCHED; PG8_LDA(At, 0, 0); PG8_STAGE_A(PG8_SA(1, 1), 1, cA, coff, a1k);
            if (Sched::UNIT_OFFS) { if (last && has_next) S.a_offs(nxt, R, C, coff); }
            PG8_WAIT_V(8); PG8_WAIT_L(0); PG8_BAR; PG8_MMA(0, 0, At, B0); PG8_MMA(0, 1, At, B1); PG8_BAR; PG8_SCHED;
            PG8_LDA(At, 0, 1); PG8_STAGE_B(PG8_SB(0, 0), b20, a2k); PG8_STAGE_B(PG8_SB(0, 1), b21, a2k); PG8_STAGE_A(PG8_SA(0, 0), 0, a2, coff, a2k);
            PG8_WAIT_V(8); PG8_WAIT_L(0); PG8_BAR; PG8_MMA(1, 0, At, B0); PG8_MMA(1, 1, At, B1); PG8_BAR; PG8_SCHED;
            PG8_LDB(B0, 1, 0); PG8_LDB(B1, 1, 1); PG8_SCHED; PG8_LDA(At, 1, 0); PG8_STAGE_A(PG8_SA(0, 1), 1, a2, coff, a2k);
            PG8_WAIT_V(8); PG8_WAIT_L(0); PG8_BAR; PG8_MMA(0, 0, At, B0); PG8_MMA(0, 1, At, B1); PG8_BAR; PG8_SCHED;
            PG8_LDA(At, 1, 1); PG8_STAGE_B(PG8_SB(1, 0), b20, a3k); PG8_STAGE_B(PG8_SB(1, 1), b21, a3k); PG8_STAGE_A(PG8_SA(1, 0), 0, a2, coff, a3k);
            PG8_WAIT_V(8); PG8_WAIT_L(0); PG8_BAR; PG8_MMA(1, 0, At, B0); PG8_MMA(1, 1, At, B1); PG8_BAR; PG8_SCHED;
        }
        if constexpr (ALIGN_EPI) { if (wr == 0) PG8_BAR; }
        { int le_; asm volatile("v_mbcnt_lo_u32_b32 %0, -1, 0\n\tv_mbcnt_hi_u32_b32 %0, -1, %0" : "=v"(le_));
          E(acc, cur, wr, wc, le_ & 15, le_ >> 4); }
        if (!has_next) break;
#pragma unroll
        for (int a = 0; a < 2; ++a)
#pragma unroll
            for (int b = 0; b < 2; ++b)
#pragma unroll
                for (int m = 0; m < 4; ++m)
#pragma unroll
                    for (int n = 0; n < 2; ++n) acc[a][b][m][n] = (f32x4){0.f, 0.f, 0.f, 0.f};
        cur = nxt; cA = nA; cB0 = nB0; cB1 = nB1; ++ui;
        if constexpr (ALIGN_EPI) { if (wr == 1) PG8_BAR; }
    }
    PG8_WAIT_V(0);
    if constexpr (!ALIGN_EPI) { if (wr == 0) PG8_BAR; }
    PG8_BAR;
#undef PG8_SA
#undef PG8_SB
#undef PG8_STAGE_A
#undef PG8_GLDS
#undef PG8_STAGE_B
#undef PG8_LDA
#undef PG8_LDB
#undef PG8_MMA
#undef PG8_WAIT_V
#undef PG8_WAIT_L
#undef PG8_BAR
#undef PG8_SCHED
}

typedef f32x4 Acc[2][2][4][2];

struct EpiProj {
    static constexpr bool PERM = true;
    bf16_t* O; int ldc; const float* bias; bool qscale; unsigned* kmax; bf16_t* kimg; bf16_t* vimg; int pn0  ;
    __device__ __forceinline__ void operator()(const Acc& acc, const Unit& u, int wr, int wc, int fr, int fq) const {
        const int row0 = u.pm * BM + wr * 64 + fr, col0 = (u.pn + pn0) * BM + wc * 32 + 8 * fq;
        const float sc = (qscale && (u.pn < 4 || (u.pn >= 12 && u.pn < 16))) ? QSCALE : 1.f;
        const bool dok = kmax != nullptr && u.pn >= 4 && u.pn < 8; float km[2] = {0.f, 0.f}; const int lane = fq * 16 + fr;
        const bool isk = kimg != nullptr && u.pn >= 4 && u.pn < 8, isv = kimg != nullptr && u.pn >= 8 && u.pn < 12;
        const unsigned bb = (unsigned)(u.pm >> 6) * (8u * 256u * 8192u); const int ktb = (u.pm & 63) * 4 + wr;
        const int kin = (wc >> 1) * 4096 + ((wc & 1) * 4 + fq) * 512 + fr * 8, vin = wc * 2048 + fr * 32 + 8 * fq;
        f32x4 bv[2][2];
#pragma unroll
        for (int bj = 0; bj < 2; ++bj)
#pragma unroll
            for (int n = 0; n < 2; ++n) bv[bj][n] = bias ? *(const f32x4*)(bias + col0 + bj * HALF + 4 * n) : (f32x4){0.f, 0.f, 0.f, 0.f};
#pragma unroll
        for (int ai = 0; ai < 2; ++ai)
#pragma unroll
            for (int m = 0; m < 4; ++m) { char* rowp = (char*)O + 2u * ((unsigned)(row0 + ai * HALF + m * 16) * (unsigned)ldc + (unsigned)col0);
#pragma unroll
                for (int bj = 0; bj < 2; ++bj) { f32x4 v0 = (acc[ai][bj][m][0] + bv[bj][0]) * sc, v1 = (acc[ai][bj][m][1] + bv[bj][1]) * sc;
                    u32x4 w; w.x = cvt_pk_bf16(v0[0], v0[1]); w.y = cvt_pk_bf16(v0[2], v0[3]); w.z = cvt_pk_bf16(v1[0], v1[1]); w.w = cvt_pk_bf16(v1[2], v1[3]);
                    if (isk) __builtin_nontemporal_store(w, (u32x4*)((char*)kimg + 2u * (bb + (unsigned)(((u.pn - 4) * 2 + bj) * 256 + ktb + 2 * ai) * 8192u + (unsigned)(kin + m * 128))));
                    else if (isv) __builtin_nontemporal_store(w, (u32x4*)((char*)vimg + 2u * (bb + (unsigned)(((u.pn - 8) * 2 + bj) * 256 + ktb + 2 * ai) * 8192u + (unsigned)(vin + m * 512))));
                    else __builtin_nontemporal_store(w, (u32x4*)(rowp + 2 * bj * HALF));
                    if (dok) { float ss = bf_lo(w.x) * bf_lo(w.x) + bf_hi(w.x) * bf_hi(w.x) + bf_lo(w.y) * bf_lo(w.y) + bf_hi(w.y) * bf_hi(w.y) + bf_lo(w.z) * bf_lo(w.z) + bf_hi(w.z) * bf_hi(w.z) + bf_lo(w.w) * bf_lo(w.w) + bf_hi(w.w) * bf_hi(w.w);
                        ss += shx(ss, 16, lane); ss += shx(ss, 32, lane); km[bj] = fmaxf(km[bj], ss); } } }
        if (dok) {
#pragma unroll
            for (int bj = 0; bj < 2; ++bj) { float v = km[bj];
#pragma unroll
                for (int o = 1; o < 16; o <<= 1) v = fmaxf(v, shx(v, o, lane));
                v *= 1.0001f;
                if (lane == 0) __hip_atomic_fetch_max(kmax + (u.pm >= (NTOK / 2) / BM ? 32 : 0) + (u.pn - 4) * 8 + bj * 4 + wc, __float_as_uint(v), RLX_AGENT); }
        }
    }
};
template <bool ADD> struct EpiGate {
    static constexpr bool PERM = true;
    bf16_t* O; const bf16_t* G; int gcol;
    __device__ __forceinline__ void operator()(const Acc& acc, const Unit& u, int wr, int wc, int fr, int fq) const {
        const int row0 = u.pm * BM + wr * 64 + fr, col0 = u.pn * BM + wc * 32 + 8 * fq;
#pragma unroll
        for (int ai = 0; ai < 2; ++ai)
#pragma unroll
            for (int mp = 0; mp < 2; ++mp)
#pragma unroll
            for (int bj = 0; bj < 2; ++bj) {
                u32x4 gg[2], tt[2];
#pragma unroll
                for (int mm = 0; mm < 2; ++mm) { const unsigned row = (unsigned)(row0 + ai * HALF + (mp * 2 + mm) * 16);
                    gg[mm] = *(const u32x4*)((const char*)G + 2u * (row * (unsigned)INW + (unsigned)(gcol + col0 + bj * HALF)));
                    tt[mm] = ADD ? *(const u32x4*)((const char*)O + 2u * (row * (unsigned)DM + (unsigned)(col0 + bj * HALF))) : (u32x4){0u, 0u, 0u, 0u}; }
#pragma unroll
                for (int mm = 0; mm < 2; ++mm) { const int m = mp * 2 + mm; const unsigned row = (unsigned)(row0 + ai * HALF + m * 16);
                    const u32x4 g = gg[mm], t = tt[mm]; char* op = (char*)O + 2u * (row * (unsigned)DM + (unsigned)(col0 + bj * HALF));
                    const f32x4 a0 = acc[ai][bj][m][0], a1 = acc[ai][bj][m][1];
                    float r[8];
                    r[0] = sigmoidf_(bf_lo(g.x)) * a0[0]; r[1] = sigmoidf_(bf_hi(g.x)) * a0[1]; r[2] = sigmoidf_(bf_lo(g.y)) * a0[2]; r[3] = sigmoidf_(bf_hi(g.y)) * a0[3];
                    r[4] = sigmoidf_(bf_lo(g.z)) * a1[0]; r[5] = sigmoidf_(bf_hi(g.z)) * a1[1]; r[6] = sigmoidf_(bf_lo(g.w)) * a1[2]; r[7] = sigmoidf_(bf_hi(g.w)) * a1[3];
                    if (ADD) { r[0] += bf_lo(t.x); r[1] += bf_hi(t.x); r[2] += bf_lo(t.y); r[3] += bf_hi(t.y); r[4] += bf_lo(t.z); r[5] += bf_hi(t.z); r[6] += bf_lo(t.w); r[7] += bf_hi(t.w); }
                    u32x4 w; w.x = cvt_pk_bf16(r[0], r[1]); w.y = cvt_pk_bf16(r[2], r[3]); w.z = cvt_pk_bf16(r[4], r[5]); w.w = cvt_pk_bf16(r[6], r[7]);
                    *(u32x4*)op = w; }
            }
    }
};
struct EpiRes {
    static constexpr bool PERM = true;
    const float* Xf; const bf16_t* Xb; bf16_t* O; const float* bias;
    __device__ __forceinline__ void operator()(const Acc& acc, const Unit& u, int wr, int wc, int fr, int fq) const {
        float alpha_; asm volatile("s_mov_b32 %0, 0x3fb504f3" : "=s"(alpha_));
        const int row0 = u.pm * BM + wr * 64 + fr, col0 = u.pn * BM + wc * 32 + 8 * fq;
        f32x4 bv[2][2];
#pragma unroll
        for (int bj = 0; bj < 2; ++bj)
#pragma unroll
            for (int n = 0; n < 2; ++n) bv[bj][n] = *(const f32x4*)(bias + col0 + bj * HALF + 4 * n);
#pragma unroll
        for (int ai = 0; ai < 2; ++ai)
#pragma unroll
            for (int mp = 0; mp < 2; ++mp) {
                f32x4 x0[2][2], x1[2][2];
#pragma unroll
                for (int mm = 0; mm < 2; ++mm)
#pragma unroll
                    for (int bj = 0; bj < 2; ++bj) { const unsigned off = (unsigned)(row0 + ai * HALF + (mp * 2 + mm) * 16) * (unsigned)DM + (unsigned)(col0 + bj * HALF);
                        if (Xb) { const u32x4 xx = *(const u32x4*)((const char*)Xb + 2u * off); x0[mm][bj] = (f32x4){bf_lo(xx.x), bf_hi(xx.x), bf_lo(xx.y), bf_hi(xx.y)}; x1[mm][bj] = (f32x4){bf_lo(xx.z), bf_hi(xx.z), bf_lo(xx.w), bf_hi(xx.w)}; }
                        else { x0[mm][bj] = *(const f32x4*)((const char*)Xf + 4u * off); x1[mm][bj] = *(const f32x4*)((const char*)Xf + 4u * off + 16); } }
#pragma unroll
                for (int mm = 0; mm < 2; ++mm)
#pragma unroll
                    for (int bj = 0; bj < 2; ++bj) { const int m = mp * 2 + mm; const unsigned off = (unsigned)(row0 + ai * HALF + m * 16) * (unsigned)DM + (unsigned)(col0 + bj * HALF);
                        const f32x4 v0 = x0[mm][bj] * alpha_ + acc[ai][bj][m][0] + bv[bj][0], v1 = x1[mm][bj] * alpha_ + acc[ai][bj][m][1] + bv[bj][1];
                        u32x4 w; w.x = cvt_pk_bf16(v0[0], v0[1]); w.y = cvt_pk_bf16(v0[2], v0[3]); w.z = cvt_pk_bf16(v1[0], v1[1]); w.w = cvt_pk_bf16(v1[2], v1[3]);
                        *(u32x4*)((char*)O + 2u * off) = w; }
            }
    }
};
struct EpiPle {
    static constexpr bool PERM = true;
    const bf16_t* X1; bf16_t* O; const bf16_t* TPP;
    __device__ __forceinline__ void operator()(const Acc& acc, const Unit& u, int wr, int wc, int fr, int fq) const {
        float alpha_; asm volatile("s_mov_b32 %0, 0x3fb504f3" : "=s"(alpha_));
        const int row0 = u.pm * BM + wr * 64 + fr, col0 = u.pn * BM + wc * 32 + 8 * fq;
#pragma unroll
        for (int ai = 0; ai < 2; ++ai)
#pragma unroll
            for (int mp = 0; mp < 2; ++mp) {
                u32x4 xs[2][2], ts[2][2];
#pragma unroll
                for (int mm = 0; mm < 2; ++mm)
#pragma unroll
                    for (int bj = 0; bj < 2; ++bj) { const unsigned off = (unsigned)(row0 + ai * HALF + (mp * 2 + mm) * 16) * (unsigned)DM + (unsigned)(col0 + bj * HALF); xs[mm][bj] = *(const u32x4*)((const char*)X1 + 2u * off); ts[mm][bj] = *(const u32x4*)((const char*)TPP + 2u * off); }
#pragma unroll
                for (int mm = 0; mm < 2; ++mm)
#pragma unroll
                    for (int bj = 0; bj < 2; ++bj) { const int m = mp * 2 + mm; const unsigned off = (unsigned)(row0 + ai * HALF + m * 16) * (unsigned)DM + (unsigned)(col0 + bj * HALF);
                        const u32x4 xx = xs[mm][bj], tp = ts[mm][bj]; const f32x4 a0 = acc[ai][bj][m][0], a1 = acc[ai][bj][m][1]; float r[8];
                        r[0] = bf_lo(xx.x) * alpha_ + sigmoidf_(a0[0]) * bf_lo(tp.x); r[1] = bf_hi(xx.x) * alpha_ + sigmoidf_(a0[1]) * bf_hi(tp.x);
                        r[2] = bf_lo(xx.y) * alpha_ + sigmoidf_(a0[2]) * bf_lo(tp.y); r[3] = bf_hi(xx.y) * alpha_ + sigmoidf_(a0[3]) * bf_hi(tp.y);
                        r[4] = bf_lo(xx.z) * alpha_ + sigmoidf_(a1[0]) * bf_lo(tp.z); r[5] = bf_hi(xx.z) * alpha_ + sigmoidf_(a1[1]) * bf_hi(tp.z);
                        r[6] = bf_lo(xx.w) * alpha_ + sigmoidf_(a1[2]) * bf_lo(tp.w); r[7] = bf_hi(xx.w) * alpha_ + sigmoidf_(a1[3]) * bf_hi(tp.w);
                        u32x4 w; w.x = cvt_pk_bf16(r[0], r[1]); w.y = cvt_pk_bf16(r[2], r[3]); w.z = cvt_pk_bf16(r[4], r[5]); w.w = cvt_pk_bf16(r[6], r[7]);
                        *(u32x4*)((char*)O + 2u * off) = w; }
            }
    }
};
}

namespace moe {
using pg8::Unit; using pg8::BM; using pg8::HALF; using pg8::Acc;
struct TabPtr { int base; __device__ __forceinline__ int operator[](int i) const { return *(const LAS int*)(uintptr_t)(unsigned)(base + 4 * i); } };
struct Tables { static constexpr TabPtr cnt{LC_CNT}, offs{LC_OFFS}, mts{LC_MTS}; };
__device__ __forceinline__ int find_expert(const Tables& T, int mt) { int e = 0;
#pragma unroll
    for (int j = 1; j < NEXP; ++j) e += (T.mts[j] <= mt) ? 1 : 0;
    return __builtin_amdgcn_readfirstlane(e); }
constexpr float XSC = 4.0f, WGUSC = 32.0f, ACTSC = 4.0f, WDNSC = 64.0f, YSC = 32.0f;
struct Sched1 {
    static constexpr bool UNIT_OFFS = true; static constexpr int SCALE_A = 0x7D7D7D7D  , SCALE_B = 0x7A7A7A7A  ;
    Tables T; const char* X1B  ; const char* WguT  ; const LAS unsigned* tokc; int G, c, total;
    static __device__ __forceinline__ bool map(int i, int G, int c, int total, int& pm, int& pn) {
        const int x = c & 7, j = c >> 3; pm = (G >> 3) * i + (G >> 5) * (x & 3) + (j >> 2); pn = 4 * (x >> 2) + (j & 3); return pm * 8 < total; }
    __device__ __forceinline__ bool next(int i, Unit& u) const { if (!map(i, G, c, total, u.pm, u.pn)) return false; u.ex = find_expert(T, u.pm) | (i << 8); return true; }
    __device__ __forceinline__ const char* a_base(const Unit&) const { return X1B; }
    __device__ __forceinline__ void a_offs(const Unit& u, const int (&R)[2], const int (&C)[2], unsigned (&off)[2][2]) const {
        const int ui = u.ex >> 8;
#pragma unroll
        for (int h = 0; h < 2; ++h)
#pragma unroll
            for (int i = 0; i < 2; ++i) off[h][i] = tokc[ui * 256 + h * HALF + R[i]] * (unsigned)DM + (unsigned)C[i] * 2u;
    }
    __device__ __forceinline__ const char* b_base(const Unit& u, int h) const { const int e = u.ex & 255; return WguT + ((size_t)e * 2048 + h * 1024 + u.pn * HALF) * DM; }
};
struct Sched2 {
    static constexpr bool UNIT_OFFS = false; static constexpr int SCALE_A = 0x7D7D7D7D  , SCALE_B = 0x79797979  ;
    Tables T; const char* ACT  ; const char* WdnT  ; int G, c, total, pn;
    __device__ __forceinline__ bool next(int i, Unit& u) const { u.pm = G * i + c; u.pn = pn; if (u.pm >= total) return false; u.ex = find_expert(T, u.pm); return true; }
    __device__ __forceinline__ const char* a_base(const Unit& u) const { return ACT + (size_t)u.pm * BM * DM; }
    __device__ __forceinline__ void a_offs(const Unit&, const int (&R)[2], const int (&C)[2], unsigned (&off)[2][2]) const {
#pragma unroll
        for (int h = 0; h < 2; ++h)
#pragma unroll
            for (int i = 0; i < 2; ++i) off[h][i] = (unsigned)((h * HALF + R[i]) * DM) + (unsigned)C[i] * 2u;
    }
    __device__ __forceinline__ const char* b_base(const Unit& u, int h) const { return WdnT + ((size_t)u.ex * 1024 + u.pn * BM + h * HALF) * DM; }
};
struct EpiAct {
    static constexpr bool PERM = true;
    unsigned char* ACT  ; const float* bgu  ;
    __device__ __forceinline__ void operator()(const Acc& acc, const Unit& u, int wr, int wc, int fr, int fq) const {
        constexpr float C1 = -1.702f * LOG2E;
        const int e = u.ex & 255; const int row0 = u.pm * BM + wr * 64 + fr, colh = wc * 32 + 8 * fq, col0 = u.pn * HALF + colh;
        const float* bg = bgu + (size_t)e * 2048 + col0; f32x2 bgc[4], bg4[4], bu1[4];
#pragma unroll
        for (int n = 0; n < 2; ++n) { const f32x4 g4_ = *(const f32x4*)(bg + 4 * n), u4_ = *(const f32x4*)(bg + 1024 + 4 * n);
            bgc[2 * n] = (f32x2){g4_[0], g4_[1]} * C1; bgc[2 * n + 1] = (f32x2){g4_[2], g4_[3]} * C1; bg4[2 * n] = (f32x2){g4_[0], g4_[1]} * ACTSC; bg4[2 * n + 1] = (f32x2){g4_[2], g4_[3]} * ACTSC;
            bu1[2 * n] = (f32x2){u4_[0], u4_[1]} + 1.0f; bu1[2 * n + 1] = (f32x2){u4_[2], u4_[3]} + 1.0f; }
#pragma unroll
        for (int ai = 0; ai < 2; ++ai)
#pragma unroll
            for (int m = 0; m < 4; ++m) { f32x2 r[4];
#pragma unroll
                for (int p = 0; p < 4; ++p) { const int n = p >> 1, j = (p & 1) * 2;
                    const f32x2 ag = (f32x2){acc[ai][0][m][n][j], acc[ai][0][m][n][j + 1]}, au = (f32x2){acc[ai][1][m][n][j], acc[ai][1][m][n][j + 1]};
                    f32x2 arg = ag * C1 + bgc[p]; arg.x = fmaxf(arg.x, 7.0f * C1); arg.y = fmaxf(arg.y, 7.0f * C1);
                    f32x2 g4 = ag * ACTSC + bg4[p]; g4.x = fminf(g4.x, 7.0f * ACTSC); g4.y = fminf(g4.y, 7.0f * ACTSC);
                    f32x2 u1 = au + bu1[p]; u1.x = __builtin_amdgcn_fmed3f(u1.x, -6.0f, 8.0f); u1.y = __builtin_amdgcn_fmed3f(u1.y, -6.0f, 8.0f);
                    f32x2 ex; ex.x = __builtin_amdgcn_exp2f(arg.x); ex.y = __builtin_amdgcn_exp2f(arg.y);
                    const f32x2 dn = ex + 1.0f; f32x2 rc; rc.x = __builtin_amdgcn_rcpf(dn.x); rc.y = __builtin_amdgcn_rcpf(dn.y);
                    r[p] = (g4 * rc) * u1; }
                u32x2 w; w.x = pk4_fp8(r[0].x, r[0].y, r[1].x, r[1].y); w.y = pk4_fp8(r[2].x, r[2].y, r[3].x, r[3].y);
                *(u32x2*)(ACT + ((unsigned)(row0 + ai * HALF + m * 16) * (unsigned)DM + (unsigned)col0)) = w; }
    }
};
struct EpiY {
    static constexpr bool PERM = true;
    unsigned char* Y  ; const float* bdn  ; const float* lgate  ; Tables T;
    __device__ __forceinline__ void operator()(const Acc& acc, const Unit& u, int wr, int wc, int fr, int fq) const {
        const int e = u.ex; const int row0 = u.pm * BM + wr * 64 + fr, col0 = u.pn * BM + wc * 32 + 8 * fq;
        const int base = T.offs[e], cnt = T.cnt[e];
#pragma unroll
        for (int bj = 0; bj < 2; ++bj) {
            const f32x4 b0 = *(const f32x4*)(bdn + (size_t)e * DM + col0 + bj * HALF), b1 = *(const f32x4*)(bdn + (size_t)e * DM + col0 + bj * HALF + 4);
#pragma unroll
            for (int ai = 0; ai < 2; ++ai)
#pragma unroll
                for (int m = 0; m < 4; ++m) { const int row = row0 + ai * HALF + m * 16; const int pos = row - base; const float g = (pos < cnt) ? lgate[(unsigned)(e * LIST_CAP + pos)] * YSC : 0.f;
                    const f32x4 v0 = (acc[ai][bj][m][0] + b0) * g, v1 = (acc[ai][bj][m][1] + b1) * g;
                    u32x2 w; w.x = pk4_fp8(v0[0], v0[1], v0[2], v0[3]); w.y = pk4_fp8(v1[0], v1[1], v1[2], v1[3]);
                    *(u32x2*)(Y + ((unsigned)row * (unsigned)DM + (unsigned)(col0 + bj * HALF))) = w; }
        }
    }
};
}

namespace att {
#ifndef PINGPONG
#define PINGPONG 0
#endif
#ifndef ATT_SB
#define ATT_SB 0
#endif
constexpr int PITCH = INW;
constexpr int KSLOT = 16384, VSLOT = 16384, NSLOT = 4, LDS_K = 0, LDS_V = NSLOT * KSLOT;
constexpr int OST = 132;
__device__ __forceinline__ int crow(int r, int hi) { return (r & 3) + 8 * (r >> 2) + 4 * hi; }
__device__ __forceinline__ void glds16(const void* gsrc, unsigned lds_dst) { unsigned keep;
    asm volatile("s_mov_b32 %0, m0\n\ts_mov_b32 m0, %2\n\ts_nop 0\n\tglobal_load_lds_dwordx4 %1, off\n\ts_mov_b32 m0, %0" : "=&s"(keep) : "v"(gsrc), "s"(lds_dst) : "memory"); }
__device__ __forceinline__ void glds16s(const void* sbase, unsigned voff, unsigned lds_dst) { unsigned keep;
    asm volatile("s_mov_b32 %0, m0\n\ts_mov_b32 m0, %3\n\ts_nop 0\n\tglobal_load_lds_dwordx4 %1, %2\n\ts_mov_b32 m0, %0" : "=&s"(keep) : "v"(voff), "s"(sbase), "s"(lds_dst) : "memory"); }
__device__ __forceinline__ void glds16s2(const void* sbase, unsigned voff, unsigned lds_dst) { unsigned keep;
    asm volatile("s_mov_b32 %0, m0\n\ts_mov_b32 m0, %3\n\ts_nop 0\n\tglobal_load_lds_dwordx4 %1, %2\n\tglobal_load_lds_dwordx4 %1, %2 offset:1024\n\ts_mov_b32 m0, %0" : "=&s"(keep) : "v"(voff), "s"(sbase), "s"(lds_dst) : "memory"); }
__device__ __forceinline__ float max3f(float a, float b, float c) { float r; asm("v_max3_f32 %0, %1, %2, %3" : "=v"(r) : "v"(a), "v"(b), "v"(c)); return r; }
typedef short v4i16_t __attribute__((ext_vector_type(4)));
__device__ __forceinline__ s16x4 vtr(const LAS unsigned char* p) { return __builtin_bit_cast(s16x4, __builtin_amdgcn_ds_read_tr16_b64_v4i16((LAS v4i16_t*)p)); }
#define ATT_WAIT_BAR(N) asm volatile("s_waitcnt vmcnt(" #N ") lgkmcnt(0)\n\ts_barrier" ::: "memory")

struct Args { const bf16_t* proj; unsigned char* out  ; const float* subw; const float* sinks; float lam, oscale; const unsigned* kmax; const bf16_t* kimg; const bf16_t* vimg; };
struct OrderTab { unsigned short v[2048]; unsigned short seg[9]; };
constexpr int est_cost(int u) { const int qt = u >> 4, h = u & 7; const int reach[8] = {5, 9, 15, 27, 52, 102, 202, 258};     const int c = 2 * qt + 2; return (c < reach[h] ? c : reach[h]) + 3; }
constexpr OrderTab make_order() { OrderTab t{};
    int gcost[64] = {}; for (int g = 0; g < 64; ++g) { const int bh = g >> 2, r = g & 3; for (int k = 0; k < 32; ++k) gcost[g] += est_cost((127 - 32 * r - k) * 16 + bh); }
    int ord[64] = {}; bool used[64] = {};
    for (int i = 0; i < 64; ++i) { int best = -1; for (int g = 0; g < 64; ++g) if (!used[g] && (best < 0 || gcost[g] > gcost[best])) best = g; used[best] = true; ord[i] = best; }
    int load[8] = {}; int own[64] = {};
    for (int i = 0; i < 64; ++i) { int x = 0; for (int j = 1; j < 8; ++j) if (load[j] < load[x]) x = j; own[ord[i]] = x; load[x] += gcost[ord[i]]; }
    int p = 0;
    for (int x = 0; x < 8; ++x) { t.seg[x] = (unsigned short)p;
        for (int i = 0; i < 64; ++i) { const int g = ord[i]; if (own[g] != x) continue; const int bh = g >> 2, r = g & 3;
            for (int k = 0; k < 32; ++k) t.v[p++] = (unsigned short)((127 - 32 * r - k) * 16 + bh); } }
    t.seg[8] = (unsigned short)p; return t; }
__device__ const OrderTab g_order = make_order();

template <bool SWA, bool FAST>
__device__ __forceinline__ void tile_loop(f32x16 (&o)[SWA ? 2 : 4], const bf16x8 (&qr)[4], float& mhat, float& lsum, int& NT, LAS unsigned char* lds, const LAS unsigned char* kp0, const LAS unsigned char* vp0,
                                          LAS float* wsf, const bf16_t* ksrc  , const bf16_t* vsrc, const unsigned koff  , const unsigned voff, const unsigned kdst, const unsigned vdst, const float cb, const float bnd,
                                          const int qt, const int q0, const int qrel, const int hi, const int r32, const int lane, const int wid, const int half) {
    constexpr int ND = SWA ? 2 : 4;
#define ATT_DMA(kt_, slot_) do { const size_t toff_ = (size_t)(kt_) * (SWA ? 64 * PITCH : 8192); const unsigned so_ = (unsigned)(slot_); \
        if (SWA) { glds16s(ksrc + toff_, koff, (unsigned)__builtin_amdgcn_readfirstlane(kdst + so_ * KSLOT)); \
                   glds16s(vsrc + toff_, voff, (unsigned)__builtin_amdgcn_readfirstlane(vdst + so_ * VSLOT)); } \
        else { glds16s2(ksrc + toff_, koff, (unsigned)__builtin_amdgcn_readfirstlane(kdst + so_ * KSLOT)); \
               glds16s2(vsrc + toff_, voff, (unsigned)__builtin_amdgcn_readfirstlane(vdst + so_ * VSLOT)); } } while (0)
#define ATT_KT(i_) ((i_) == 0 ? 2 * qt : ((i_) == 1 ? 2 * qt + 1 : 2 * qt + 1 - (i_)))
    ATT_DMA(ATT_KT(0), 0); ATT_DMA(ATT_KT(1), 1); if (NT > 2) ATT_DMA(ATT_KT(2), 2);
    if (SWA && NT > 3) ATT_DMA(ATT_KT(3), 3);
    int g = 0;
#define ATT_BARRIER() do { \
        if ((g & 1) == 0) { const int t_ = g >> 1; if (SWA) { if (t_ == 0) ATT_WAIT_BAR(0); }   \
            else if (t_ + 2 < NT) ATT_WAIT_BAR(8); else if (t_ + 1 < NT) ATT_WAIT_BAR(4); else ATT_WAIT_BAR(0); } \
        else { if (PINGPONG) asm volatile("s_waitcnt lgkmcnt(0)\n\ts_barrier" ::: "memory"); } \
        if (!SWA && g == 2) { \
            const LAS float* dq = (const LAS float*)(lds + LC_WSF) + 8 * 64; float dmax = dq[0]; \
            _Pragma("unroll") for (int w = 1; w < 8; ++w) dmax = fmaxf(dmax, dq[w]); \
            const float lim = ((float)(q0 - 63) - (dmax + 2.0f)) * (1.0f / 64.0f); \
            int kt_lo = (int)ceilf(lim); kt_lo = kt_lo < 0 ? 0 : kt_lo; kt_lo = __builtin_amdgcn_readfirstlane(kt_lo); \
            const int ntn = 2 * qt + 2 - kt_lo; NT = ntn < 2 ? 2 : (ntn < NT ? ntn : NT); } \
        if (!SWA && (g & 1)) { const int t2_ = (g >> 1) + 3; if (t2_ < NT) { const int s2_ = t2_ & 3; ATT_DMA(ATT_KT(t2_), s2_); } } \
        ++g; } while (0)
    if (PINGPONG && half == 1) ATT_BARRIER();
    float cstep[8];
#pragma unroll
    for (int m = 1; m < 8; ++m) cstep[m] = __builtin_bit_cast(float, __builtin_amdgcn_readfirstlane(__builtin_bit_cast(int, cb * (float)(8 * m))));
#define ATT_CINIT() do { float bs_[4]; bs_[0] = nb; bs_[1] = nb + cb; bs_[2] = fmaf(cb, 2.0f, nb); bs_[3] = fmaf(cb, 3.0f, nb); \
        _Pragma("unroll") for (int r = 0; r < 16; ++r) { const int m_ = r >> 2; float a_, b_; \
            if (m_ == 0) a_ = bs_[r & 3]; else asm("v_add_f32 %0, %1, %2" : "=v"(a_) : "s"(cstep[m_]), "v"(bs_[r & 3])); \
            asm("v_add_f32 %0, %1, %2" : "=v"(b_) : "s"(cstep[m_ + 4]), "v"(bs_[r & 3])); c0[r] = a_; c1[r] = b_; } } while (0)
    int slot = 0;
#pragma unroll 1
    for (int i = 0; i < NT; ++i) {
        ATT_BARRIER();
        if (SWA) { const bool lowq = (wid & 3) < 2; if (lowq ? (i == 1) : (i == 3)) { ATT_BARRIER(); slot = (slot + 1) & 3; continue; } }
        const int kt = ATT_KT(i); const int rel = 64 * (kt - 2 * qt);
        const LAS unsigned char* kp = kp0 + slot * KSLOT;
        const float nb = -mhat - cb * (float)(qrel - rel - 4 * hi);
        f32x16 c0, c1;
        if (FAST) {
            bf16x8 kf[8];
#pragma unroll
            for (int d0 = 0; d0 < 4; ++d0) { kf[2 * d0] = *(const LAS bf16x8*)(kp + d0 * 2048); kf[2 * d0 + 1] = *(const LAS bf16x8*)(kp + d0 * 2048 + 512); }
            ATT_CINIT();
            __builtin_amdgcn_sched_barrier(0);
#pragma unroll
            for (int d0 = 0; d0 < 4; ++d0) {
                c0 = __builtin_amdgcn_mfma_f32_32x32x16_bf16(kf[2 * d0], qr[d0], c0, 0, 0, 0);
                c1 = __builtin_amdgcn_mfma_f32_32x32x16_bf16(kf[2 * d0 + 1], qr[d0], c1, 0, 0, 0);
            }
            __builtin_amdgcn_sched_barrier(0);
        } else {
            ATT_CINIT();
#pragma unroll
            for (int d0 = 0; d0 < 4; ++d0) {
                const bf16x8 k0 = *(const LAS bf16x8*)(kp + d0 * 2048), k1 = *(const LAS bf16x8*)(kp + d0 * 2048 + 512);
                c0 = __builtin_amdgcn_mfma_f32_32x32x16_bf16(k0, qr[d0], c0, 0, 0, 0);
                c1 = __builtin_amdgcn_mfma_f32_32x32x16_bf16(k1, qr[d0], c1, 0, 0, 0);
            }
        }
        if (SWA ? (((wid & 3) < 2) ? (i != 2) : (i != 0)) : (i < 2)) {
            const int dd = qrel - rel - 4 * hi;
#pragma unroll
            for (int r = 0; r < 16; ++r) { const int d0_ = dd - ((r & 3) + 8 * (r >> 2)), d1_ = d0_ - 32;
                const bool v0 = SWA ? ((unsigned)d0_ < 128u) : (d0_ >= 0), v1 = SWA ? ((unsigned)d1_ < 128u) : (d1_ >= 0);
                c0[r] = v0 ? c0[r] : -INFINITY; c1[r] = v1 ? c1[r] : -INFINITY; }
        }
        float fsc = 1.0f;
        if (!FAST || i == 0) {
        float rm = max3f(c0[0], c1[0], c0[1]), rm2 = max3f(c1[1], c0[2], c1[2]);
#pragma unroll
        for (int r = 3; r < 15; r += 2) { rm = max3f(rm, c0[r], c1[r]); rm2 = max3f(rm2, c0[r + 1], c1[r + 1]); }
        rm = max3f(rm, c0[15], c1[15]); rm = max3f(rm, rm2, rm2);
        { auto rr = __builtin_amdgcn_permlane32_swap(__float_as_uint(rm), __float_as_uint(rm), false, false); rm = max3f(__uint_as_float(rr[0]), __uint_as_float(rr[1]), __uint_as_float(rr[1])); }
        if (i == 0) {
            mhat = rm;
#pragma unroll
            for (int r = 0; r < 16; ++r) { c0[r] -= rm; c1[r] -= rm; }
            if (!SWA) { float tq = (bnd - mhat + 128.0f) / cb;
#pragma unroll
                for (int o_ = 1; o_ < 32; o_ <<= 1) tq = fmaxf(tq, shx(tq, o_, lane));
                if (lane == 0) ((LAS float*)(lds + LC_WSF))[8 * 64 + wid] = tq; }
        } else if (!FAST) {
            const float dl = rm > 8.0f ? rm : 0.f; mhat += dl;
#pragma unroll
            for (int r = 0; r < 16; ++r) { c0[r] -= dl; c1[r] -= dl; }
            fsc = __builtin_amdgcn_exp2f(-dl); lsum *= fsc;
        }
        }
        if (!FAST) {
            if (hi == 0) wsf[r32] = fsc;
            asm volatile("s_waitcnt lgkmcnt(0)" ::: "memory");
#pragma unroll
            for (int r = 0; r < 16; ++r) { const float fr_ = wsf[crow(r, hi)];
#pragma unroll
                for (int d = 0; d < ND; ++d) { float t_ = o[d][r]; asm("v_mul_f32 %0, %1, %0" : "+v"(t_) : "v"(fr_)); o[d][r] = t_; } }
            asm volatile("s_waitcnt lgkmcnt(0)" ::: "memory");
        }
        float sacc = 0.f;
#pragma unroll
        for (int r = 0; r < 16; ++r) { c0[r] = __builtin_amdgcn_exp2f(c0[r]); c1[r] = __builtin_amdgcn_exp2f(c1[r]); sacc += c0[r] + c1[r]; }
        lsum += sacc;
        u32x4 pw[4];
#pragma unroll
        for (int j = 0; j < 4; ++j) { pw[0][j] = cvt_pk_bf16(c0[2 * j], c0[2 * j + 1]); pw[1][j] = cvt_pk_bf16(c0[8 + 2 * j], c0[9 + 2 * j]);
                                      pw[2][j] = cvt_pk_bf16(c1[2 * j], c1[2 * j + 1]); pw[3][j] = cvt_pk_bf16(c1[8 + 2 * j], c1[9 + 2 * j]); }
        ATT_BARRIER();
        const LAS unsigned char* vp = vp0 + slot * VSLOT;
        s16x4 vlo[2][4], vhi[2][4];
#define ATT_VLOAD(buf, d) do { _Pragma("unroll") for (int ks = 0; ks < 4; ++ks) { vlo[buf][ks] = vtr(vp + (d) * 4096 + ks * 1024); vhi[buf][ks] = vtr(vp + (d) * 4096 + ks * 1024 + 512); } } while (0)
#define ATT_VMMA(buf, d) do { _Pragma("unroll") for (int ks = 0; ks < 4; ++ks) { \
            const s16x4 lo_ = vlo[buf][ks], hh_ = vhi[buf][ks]; const bf16x8 vf_ = (bf16x8){lo_[0], lo_[1], lo_[2], lo_[3], hh_[0], hh_[1], hh_[2], hh_[3]}; \
            o[d] = __builtin_amdgcn_mfma_f32_32x32x16_bf16(__builtin_bit_cast(bf16x8, pw[ks]), vf_, o[d], 0, 0, 0); } } while (0)
        if (FAST) {
            ATT_VLOAD(0, 0); ATT_VLOAD(1, 1);
            __builtin_amdgcn_sched_barrier(0);
            ATT_VMMA(0, 0);
            __builtin_amdgcn_sched_barrier(0);
            ATT_VLOAD(0, 2); __builtin_amdgcn_sched_barrier(0);
            ATT_VMMA(1, 1);
            __builtin_amdgcn_sched_barrier(0);
            ATT_VLOAD(1, 3); __builtin_amdgcn_sched_barrier(0); ATT_VMMA(0, 2); __builtin_amdgcn_sched_barrier(0); ATT_VMMA(1, 3); __builtin_amdgcn_sched_barrier(0);
        } else {
#pragma unroll
            for (int d = 0; d < ND; ++d) { ATT_VLOAD(0, d); __builtin_amdgcn_sched_barrier(0); ATT_VMMA(0, d); __builtin_amdgcn_sched_barrier(0); }
        }
#undef ATT_VLOAD
#undef ATT_VMMA
        slot = (slot + 1) & 3;
    }
    if (PINGPONG && half == 0) ATT_BARRIER();
#undef ATT_BARRIER
#undef ATT_DMA
#undef ATT_KT
}
template <bool SWA>
__device__ __forceinline__ void attn_unit(const Args& A, int uid, LAS unsigned char* lds, const int wave_) {
    int l_; asm volatile("v_mbcnt_lo_u32_b32 %0, -1, 0\n\tv_mbcnt_hi_u32_b32 %0, -1, %0" : "=v"(l_));
    const int tid = wave_ * 64 + l_;
    constexpr int ND = SWA ? 2 : 4;
    constexpr int NDMA = SWA ? 2 : 4;
    const int lane = tid & 63, r32 = lane & 31, hi = lane >> 5;
    const int wid = __builtin_amdgcn_readfirstlane(tid >> 6), half = wid >> 2, quarter = wid & 3;
    int b, qt, hsel, kvh = 0, ocol0; float slope;
    if (!SWA) { const int bh = uid & 15; qt = uid >> 4; b = bh >> 3; hsel = bh & 7; slope = __builtin_amdgcn_exp2f(-(float)(hsel + 1)); ocol0 = hsel * 128; }
    else { b = uid & 1; kvh = (uid >> 1) & 1; const int j = (uid >> 2) & 3; qt = uid >> 4; hsel = kvh * 8 + 2 * j; slope = __builtin_amdgcn_exp2f(-0.5f * (float)(hsel + half + 1)); ocol0 = hsel * 64; }
    const float cb = slope * LOG2E;
    const size_t rowbase = (size_t)b * SEQ; const int q0 = qt * 128;
    const bf16_t* Qw = A.proj + (rowbase + q0 + quarter * 32) * PITCH + (SWA ? (COL_SQ + (hsel + half) * 64) : (COL_DQ + hsel * 128 + half * 64));
    const bf16_t* Kg = A.proj + rowbase * PITCH + (SWA ? (COL_SK + kvh * 64) : (COL_DK + hsel * 128));
    const bf16_t* Vg = A.proj + rowbase * PITCH + (SWA ? (COL_SV + kvh * 64) : (COL_DV + hsel * 128));
    const unsigned lds0 = (unsigned)(uintptr_t)lds;
    const bf16_t* ksrc = SWA ? Kg : A.kimg + (size_t)(b * 8 + hsel) * 256 * 8192;
    const bf16_t* vsrc = SWA ? Vg : A.vimg + (size_t)(b * 8 + hsel) * 256 * 8192;
    const unsigned koff = 2u * (unsigned)(SWA ? lane * PITCH + wid * 8 : wid * 1024 + lane * 8);
    const unsigned voff = 2u * (unsigned)(SWA ? (16 * (wid & 3) + (lane >> 2)) * PITCH + (wid >> 2) * 32 + (lane & 3) * 8 : wid * 1024 + lane * 8);
    const unsigned kdst = lds0 + LDS_K + wid * (SWA ? 1024 : 2048), vdst = lds0 + LDS_V + wid * (SWA ? 1024 : 2048);
    const LAS unsigned char* kp0 = lds + LDS_K + (SWA ? 0 : half * 8192) + hi * 1024 + r32 * 16;
    const LAS unsigned char* vp0 = lds + LDS_V + ((lane >> 4) & 1) * 32 + (lane & 3) * 8 + (4 * hi + ((lane & 15) >> 2)) * 64;
    LAS float* wsf = (LAS float*)(lds + LC_WSF) + wid * 64;
    bf16x8 qr[4];
#pragma unroll
    for (int d0 = 0; d0 < 4; ++d0) qr[d0] = *(const bf16x8*)(Qw + (size_t)r32 * PITCH + d0 * 16 + hi * 8);
    int NT = SWA ? (qt == 0 ? 2 : 4) : (2 * qt + 2);
    float bnd = 0.f;
    if (!SWA) { float qn = 0.f;
#pragma unroll
        for (int d0 = 0; d0 < 4; ++d0)
#pragma unroll
            for (int e = 0; e < 8; ++e) { const float qv = __uint_as_float(((unsigned)(unsigned short)qr[d0][e]) << 16); qn += qv * qv; }
        { auto rr = __builtin_amdgcn_permlane32_swap(__float_as_uint(qn), __float_as_uint(qn), false, false); qn = __uint_as_float(rr[0]) + __uint_as_float(rr[1]); }
        const unsigned* kmp = A.kmax + b * 32 + hsel * 4 + half * 2;
        const float k2 = __uint_as_float(__hip_atomic_load(kmp, RLX_AGENT)) + __uint_as_float(__hip_atomic_load(kmp + 1, RLX_AGENT));
        bnd = sqrtf(qn * k2) * 1.001f + 0.01f; }
    f32x16 o[ND];
#pragma unroll
    for (int d = 0; d < ND; ++d) o[d] = f32x16{};
    float mhat = 0.f, lsum = 0.f;
    const int qrel = quarter * 32 + r32;
    if (!SWA && !__any(bnd > 48.0f)) tile_loop<SWA, true>(o, qr, mhat, lsum, NT, lds, kp0, vp0, wsf, ksrc, vsrc, koff, voff, kdst, vdst, cb, bnd, qt, q0, qrel, hi, r32, lane, wid, half);
    else tile_loop<SWA, false>(o, qr, mhat, lsum, NT, lds, kp0, vp0, wsf, ksrc, vsrc, koff, voff, kdst, vdst, cb, bnd, qt, q0, qrel, hi, r32, lane, wid, half);
    int le_; asm volatile("v_mbcnt_lo_u32_b32 %0, -1, 0\n\tv_mbcnt_hi_u32_b32 %0, -1, %0" : "=v"(le_));
    const int tid_e = wave_ * 64 + le_, r32_e = le_ & 31, hi_e = le_ >> 5;
    LAS float* wsf_e = (LAS float*)(lds + LC_WSF) + wid * 64;
    { auto rr = __builtin_amdgcn_permlane32_swap(__float_as_uint(lsum), __float_as_uint(lsum), false, false); lsum = __uint_as_float(rr[0]) + __uint_as_float(rr[1]); }
    if (SWA) lsum += __builtin_amdgcn_exp2f(A.sinks[hsel + half] * LOG2E - mhat);
    if (hi_e == 0) wsf_e[32 + r32_e] = lsum;
    asm volatile("s_waitcnt lgkmcnt(0)" ::: "memory");
    float rli[16];
#pragma unroll
    for (int r = 0; r < 16; ++r) rli[r] = __builtin_amdgcn_rcpf(wsf_e[32 + crow(r, hi_e)]);
    ATT_WAIT_BAR(0);
    LAS float* ost = (LAS float*)(lds + LDS_K);
    if (!SWA) {
        if (half == 1) {
#pragma unroll
            for (int r = 0; r < 16; ++r)
#pragma unroll
                for (int d = 0; d < ND; ++d) ost[(quarter * 32 + crow(r, hi_e)) * OST + d * 32 + r32_e] = A.lam * o[d][r] * rli[r];
        }
        ATT_WAIT_BAR(0);
        if (half == 0) {
#pragma unroll
            for (int r = 0; r < 16; ++r)
#pragma unroll
                for (int d = 0; d < ND; ++d) { LAS float* p = ost + (quarter * 32 + crow(r, hi_e)) * OST + d * 32 + r32_e; *p = o[d][r] * rli[r] - *p; }
        }
        ATT_WAIT_BAR(0);
    } else {
#pragma unroll
        for (int r = 0; r < 16; ++r)
#pragma unroll
            for (int d = 0; d < ND; ++d) ost[(quarter * 32 + crow(r, hi_e)) * OST + half * 64 + d * 32 + r32_e] = o[d][r] * rli[r];
        ATT_WAIT_BAR(0);
    }
    {
        const int row = tid_e >> 2, cq = tid_e & 3; const LAS float* p = ost + row * OST + cq * 32; f32x4 v[8]; float ss = 0.f;
#pragma unroll
        for (int j = 0; j < 8; ++j) { v[j] = *(const LAS f32x4*)(p + 4 * j); ss += v[j][0] * v[j][0] + v[j][1] * v[j][1] + v[j][2] * v[j][2] + v[j][3] * v[j][3]; }
        float rs = 1.f;
        if (!SWA) { ss += dpp_xor1(ss); ss += dpp_xor2(ss); rs = A.oscale / sqrtf(ss * (1.0f / 128.0f) + RMS_EPS); }
        unsigned char* op = A.out + (rowbase + q0 + row) * DM + ocol0 + cq * 32;
        rs *= ATT_OSC;
#pragma unroll
        for (int j = 0; j < 8; j += 2) { f32x4 a = v[j] * rs, c = v[j + 1] * rs;
            if (!SWA) { const f32x4 w0 = *(const f32x4*)(A.subw + cq * 32 + 4 * j), w1 = *(const f32x4*)(A.subw + cq * 32 + 4 * j + 4); a = a * w0; c = c * w1; }
            u32x2 w; w.x = pk4_fp8(a[0], a[1], a[2], a[3]); w.y = pk4_fp8(c[0], c[1], c[2], c[3]);
            *(u32x2*)(op + 4 * j) = w; }
    }
    ATT_WAIT_BAR(0);
}
template <bool SWA, class BgF>
__device__ __forceinline__ void attn_phase(const Args& A, unsigned* qhead, int nunits, LAS unsigned char* lds, const int wave, const BgF& bgf, const int bid, const bool bgon) {
    volatile LAS unsigned* bc = (volatile LAS unsigned*)(lds + LC_MISC) + 16;
    const int myx = SWA ? 0 : (int)((unsigned)__builtin_amdgcn_s_getreg((3 << 11) | 20) & 7u);
    int cnt = bid;
#pragma unroll 1
    for (int pass = 0; pass < (SWA ? 1 : 8); ++pass) {
        const int x = (myx + pass) & 7; const int s0 = SWA ? 0 : (int)g_order.seg[x], s1 = SWA ? nunits : (int)g_order.seg[x + 1];
        if (!SWA && pass >= 1) {
            if (pass == 1) { int l_; asm volatile("v_mbcnt_lo_u32_b32 %0, -1, 0\n\tv_mbcnt_hi_u32_b32 %0, -1, %0" : "=v"(l_));
                if (wave == 0 && l_ < 8) bc[4 + l_] = __hip_atomic_load(qhead + 64 * l_, RLX_AGENT);
                __syncthreads(); }
            if ((int)bc[4 + x] >= s1 - s0) continue;
        }
        for (;;) {
            const bool wantbg = bgon && (cnt % BgF::EVERY) == 0; ++cnt;
            { int l_; asm volatile("v_mbcnt_lo_u32_b32 %0, -1, 0\n\tv_mbcnt_hi_u32_b32 %0, -1, %0" : "=v"(l_));
              if (wave == 0 && l_ == 0) { const unsigned a_ = __hip_atomic_fetch_add(qhead + (SWA ? 0 : 64 * x), 1u, RLX_AGENT); unsigned b_ = (unsigned)BgF::TOTAL;
                  if (wantbg) b_ = __hip_atomic_fetch_add(bgf.ctr, 1u, RLX_AGENT); bc[0] = a_; bc[1] = b_; } }
            __syncthreads();
            const int u = s0 + (int)bc[0]; const int bi = (int)bc[1];
            __syncthreads();
            if (u >= s1) { if (bi < BgF::TOTAL) bgf(bi, lds, wave); break; }
            if (bi < BgF::TOTAL) bgf(bi, lds, wave);
            attn_unit<SWA>(A, SWA ? u : (int)g_order.v[u], lds, wave);
        }
    }
}
template <class BgF>
__device__ __forceinline__ void bg_drain(LAS unsigned char* lds, const int wave, const BgF& bgf) {
    volatile LAS unsigned* bc = (volatile LAS unsigned*)(lds + LC_MISC) + 16;
    for (;;) {
        { int l_; asm volatile("v_mbcnt_lo_u32_b32 %0, -1, 0\n\tv_mbcnt_hi_u32_b32 %0, -1, %0" : "=v"(l_));
          if (wave == 0 && l_ == 0) bc[1] = __hip_atomic_fetch_add(bgf.ctr, 1u, RLX_AGENT); }
        __syncthreads();
        const int bi = (int)bc[1];
        __syncthreads();
        if (bi >= BgF::TOTAL) break;
        bgf(bi, lds, wave);
    }
    __syncthreads();
}
}

#define XB_TMO      128
#define XB_XCNT(j)  (256  + 64 * (j))
#define XB_XSUB(j)  (1280 + 64 * (j))
#define XB_XGEN(j)  (2304 + 64 * (j))
#define XB_TOP      3328
#define XB_TOPGEN   3392
#define XCD_BAR_WORDS 3456
#define XB_SPIN_CAP (1u << 18)
__device__ __forceinline__ unsigned xb_ld(unsigned* p)              { return __hip_atomic_load(p, __ATOMIC_RELAXED, __HIP_MEMORY_SCOPE_AGENT); }
__device__ __forceinline__ unsigned xb_add(unsigned* p, unsigned v) { return __hip_atomic_fetch_add(p, v, __ATOMIC_RELAXED, __HIP_MEMORY_SCOPE_AGENT); }
__device__ __forceinline__ unsigned xb_xcc_id() { return (unsigned)__builtin_amdgcn_s_getreg((3 << 11) | 20) & 0xFu; }
#define XB_SPIN(cond, bar) do { unsigned _sp = 0; while (cond) { __builtin_amdgcn_s_sleep(1); \
    if ((++_sp & 255u) == 0u) { if (xb_ld(&(bar)[XB_TMO])) break; if (_sp > XB_SPIN_CAP) { atomicAdd(&(bar)[XB_TMO], 1u); break; } } } } while (0)
struct XcdBarrier { unsigned* bar; unsigned x; volatile LAS unsigned* st; };
__device__ __forceinline__ XcdBarrier xcd_barrier_post(unsigned* bar, volatile LAS unsigned* st) {
    XcdBarrier b; b.bar = bar; b.x = xb_xcc_id(); b.st = st;
    if (threadIdx.x == 0) (void)xb_add(&bar[XB_XCNT(b.x)], 1u);
    return b;
}
__device__ __forceinline__ void xcd_barrier_complete(unsigned* bar, unsigned x, unsigned& nloc, unsigned& nx) {
    const unsigned G = gridDim.x * gridDim.y * gridDim.z;
    unsigned sum, cnt, mine, sp = 0u;
    for (;;) {
        sum = 0u; cnt = 0u; mine = 0u;
#pragma unroll
        for (unsigned j = 0; j < 16; ++j) { const unsigned c = xb_ld(&bar[XB_XCNT(j)]); sum += c; cnt += (c > 0u) ? 1u : 0u; mine = (j == x) ? c : mine; }
        if (sum == G) break;
        __builtin_amdgcn_s_sleep(1);
        if ((++sp & 255u) == 0u) { if (xb_ld(&bar[XB_TMO])) break; if (sp > XB_SPIN_CAP) { atomicAdd(&bar[XB_TMO], 1u); break; } }
    }
    nloc = mine > 0u ? mine : 1u; nx = cnt > 0u ? cnt : 1u;
}
__device__ __forceinline__ void xcd_barrier(const XcdBarrier& b) {
    asm volatile("s_waitcnt vmcnt(0)" ::: "memory");
    __syncthreads();
    if (threadIdx.x == 0) {
        unsigned* bar = b.bar;
        __builtin_amdgcn_s_waitcnt(0);
        unsigned nloc = b.st[0], nx = b.st[1];
        if (nloc == 0u) { xcd_barrier_complete(bar, b.x, nloc, nx); b.st[0] = nloc; b.st[1] = nx; }
        const unsigned old = xb_add(&bar[XB_XSUB(b.x)], 1u);
        const unsigned gen = old / nloc;
        if (old + 1u == (gen + 1u) * nloc) {
            __builtin_amdgcn_fence(__ATOMIC_RELEASE, "agent");
            asm volatile("s_waitcnt vmcnt(0)" ::: "memory");
            const unsigned og = xb_add(&bar[XB_TOP], 1u);
            const unsigned tg = og / nx;
            if (og + 1u == (tg + 1u) * nx) xb_add(&bar[XB_TOPGEN], 1u);
            else XB_SPIN(xb_ld(&bar[XB_TOPGEN]) == tg, bar);
            __builtin_amdgcn_fence(__ATOMIC_ACQUIRE, "agent");
            xb_add(&bar[XB_XGEN(b.x)], 1u);
            asm volatile("s_waitcnt vmcnt(0)" ::: "memory");
        } else {
            XB_SPIN(xb_ld(&bar[XB_XGEN(b.x)]) == gen, bar);
            __builtin_amdgcn_fence(__ATOMIC_ACQUIRE, "agent");
            asm volatile("s_waitcnt vmcnt(0)" ::: "memory");
        }
    }
    __syncthreads();
}

constexpr int NWAVES = 8;
struct Frame { LAS unsigned char* lds; unsigned* ctl; int tid, lane, wave, G, bid; };

__device__ __forceinline__ unsigned f2bf(float f) { unsigned u = __builtin_bit_cast(unsigned, f); return (u + 0x7fffu + ((u >> 16) & 1u)) >> 16; }
__device__ __forceinline__ unsigned pk2(float lo, float hi) { return f2bf(lo) | (f2bf(hi) << 16); }

__device__ __forceinline__ void p0_transpose_item(const float* W, int K, int N, bf16_t* WT, LAS float* scr, int item, int lane) {
    const int nblk = N / 32, kb = item / nblk, nb = item % nblk, k0 = 64 * kb, n0 = 32 * nb;
    float wv_[32];
#pragma unroll
    for (int i = 0; i < 32; ++i) wv_[i] = W[(size_t)(k0 + 2 * i + (lane >> 5)) * N + n0 + (lane & 31)];
#pragma unroll
    for (int i = 0; i < 32; ++i) scr[(2 * i + (lane >> 5)) * 33 + (lane & 31)] = wv_[i];
    LDS_WAIT(); asm volatile("" ::: "memory");
    const int c = lane & 7;
#pragma unroll
    for (int j = 0; j < 4; ++j) { const int n = (lane >> 3) + 8 * j; const LAS float* s = scr + (8 * c) * 33 + n;
        u32x4 o; o.x = pk2(s[0 * 33], s[1 * 33]); o.y = pk2(s[2 * 33], s[3 * 33]); o.z = pk2(s[4 * 33], s[5 * 33]); o.w = pk2(s[6 * 33], s[7 * 33]);
        *(u32x4*)(WT + (size_t)(n0 + n) * K + k0 + 8 * c) = o; }
    LDS_WAIT(); asm volatile("" ::: "memory");
}
__device__ __forceinline__ void bg_tile_load(float (&v)[64], const float* W, int N, int k0, int n0, int lane) {
    const float* src = W + (size_t)(k0 + 64 * (lane >> 5)) * N + n0 + (lane & 31);
#pragma unroll
    for (int i = 0; i < 64; ++i) v[i] = src[(size_t)i * N];
}
__device__ __forceinline__ void bg_tile_store(const float (&v)[64], unsigned char* WT, int K, int k0, int n0, int lane, float sc) {
    unsigned char* dst = WT + (size_t)(n0 + (lane & 31)) * K + k0 + 64 * (lane >> 5);
#pragma unroll
    for (int q = 0; q < 4; ++q) { u32x4 o;
        o.x = pk4_fp8(v[16 * q + 0] * sc, v[16 * q + 1] * sc, v[16 * q + 2] * sc, v[16 * q + 3] * sc);     o.y = pk4_fp8(v[16 * q + 4] * sc, v[16 * q + 5] * sc, v[16 * q + 6] * sc, v[16 * q + 7] * sc);
        o.z = pk4_fp8(v[16 * q + 8] * sc, v[16 * q + 9] * sc, v[16 * q + 10] * sc, v[16 * q + 11] * sc);   o.w = pk4_fp8(v[16 * q + 12] * sc, v[16 * q + 13] * sc, v[16 * q + 14] * sc, v[16 * q + 15] * sc);
        *(u32x4*)(dst + 16 * q) = o; }
}
__device__ __forceinline__ void p0_transpose_stack(const Frame& F, const float* W, bf16_t* WT, int nmat, int K, int N, LAS float* scr) {
    const int per = (K / 64) * (N / 32), total = nmat * per; const int gw = F.bid * NWAVES + F.wave, NGW = F.G * NWAVES;
    for (int it = gw; it < total; it += NGW) { const int mi = it / per, r = it % per; p0_transpose_item(W + (size_t)mi * K * N, K, N, WT + (size_t)mi * K * N, scr, r, F.lane); }
}
__device__ __forceinline__ void cvt_rows_bf16(const Frame& F, const float* __restrict__ src, bf16_t* __restrict__ dst, size_t n  , unsigned char* __restrict__ dst8 = nullptr  ) {
    const size_t gt = (size_t)F.bid * (NWAVES * 64) + F.tid, NT = (size_t)F.G * NWAVES * 64;
    for (size_t i0 = gt * 8; i0 < n; i0 += NT * 8 * 4) { f32x4 a[4], b[4];
#pragma unroll
        for (int q = 0; q < 4; ++q) { const size_t i = i0 + (size_t)q * NT * 8; if (i < n) { a[q] = *(const f32x4*)(src + i); b[q] = *(const f32x4*)(src + i + 4); } }
#pragma unroll
        for (int q = 0; q < 4; ++q) { const size_t i = i0 + (size_t)q * NT * 8; if (i < n) {
            u32x4 w; w.x = cvt_pk_bf16(a[q][0], a[q][1]); w.y = cvt_pk_bf16(a[q][2], a[q][3]); w.z = cvt_pk_bf16(b[q][0], b[q][1]); w.w = cvt_pk_bf16(b[q][2], b[q][3]); *(u32x4*)(dst + i) = w;
            if (dst8) { u32x2 w8; w8.x = pk4_fp8(a[q][0] * XIN_SC, a[q][1] * XIN_SC, a[q][2] * XIN_SC, a[q][3] * XIN_SC); w8.y = pk4_fp8(b[q][0] * XIN_SC, b[q][1] * XIN_SC, b[q][2] * XIN_SC, b[q][3] * XIN_SC); *(u32x2*)(dst8 + i) = w8; } } } }
}

__device__ __forceinline__ void moe_tables(const Frame& F, const unsigned* gcnt  ) {
    LAS int* cnt = (LAS int*)(F.lds + LC_CNT); LAS int* offs = (LAS int*)(F.lds + LC_OFFS); LAS int* mts = (LAS int*)(F.lds + LC_MTS);
    __syncthreads();
    if (F.tid < NEXP) cnt[F.tid] = (int)__hip_atomic_load(gcnt + 64 * F.tid, RLX_AGENT);
    __syncthreads();
    if (F.tid == 0) { int o = 0; for (int e = 0; e < NEXP; ++e) { offs[e] = o; mts[e] = o >> 8; o += (cnt[e] + 255) & ~255; } offs[NEXP] = o; mts[NEXP] = o >> 8; }
    __syncthreads();
}

__device__ __forceinline__ void ln_row_stats(f32x4 (&v)[4], const f32x4 (&gg)[4], const f32x4 (&bb)[4], int lane, float& mean_o, float& rstd_o) {
    float s = 0.f;
#pragma unroll
    for (int j = 0; j < 4; ++j) s += (v[j][0] + v[j][1]) + (v[j][2] + v[j][3]);
    const float mean = wave_sum(s, lane) * (1.f / DM); float s2 = 0.f;
#pragma unroll
    for (int j = 0; j < 4; ++j) { v[j] = v[j] - mean; s2 += (v[j][0] * v[j][0] + v[j][1] * v[j][1]) + (v[j][2] * v[j][2] + v[j][3] * v[j][3]); }
    const float rstd = 1.f / sqrtf(wave_sum(s2, lane) * (1.f / DM) + LN_EPS);
#pragma unroll
    for (int j = 0; j < 4; ++j) v[j] = v[j] * rstd * gg[j] + bb[j];
    mean_o = mean; rstd_o = rstd;
}
__device__ __forceinline__ void ln_row_pre(f32x4 (&v)[4], const f32x4 (&gg)[4], const f32x4 (&bb)[4], int lane) {
    float s = 0.f;
#pragma unroll
    for (int j = 0; j < 4; ++j) s += (v[j][0] + v[j][1]) + (v[j][2] + v[j][3]);
    const float mean = wave_sum(s, lane) * (1.f / DM); float s2 = 0.f;
#pragma unroll
    for (int j = 0; j < 4; ++j) { v[j] = v[j] - mean; s2 += (v[j][0] * v[j][0] + v[j][1] * v[j][1]) + (v[j][2] * v[j][2] + v[j][3] * v[j][3]); }
    const float rstd = 1.f / sqrtf(wave_sum(s2, lane) * (1.f / DM) + LN_EPS);
#pragma unroll
    for (int j = 0; j < 4; ++j) v[j] = v[j] * rstd * gg[j] + bb[j];
}
__device__ __forceinline__ void ln_row(f32x4 (&v)[4], const float* g, const float* bta, int lane) {
    float s = 0.f;
#pragma unroll
    for (int j = 0; j < 4; ++j) s += (v[j][0] + v[j][1]) + (v[j][2] + v[j][3]);
    const float mean = wave_sum(s, lane) * (1.f / DM); float s2 = 0.f;
#pragma unroll
    for (int j = 0; j < 4; ++j) { v[j] = v[j] - mean; s2 += (v[j][0] * v[j][0] + v[j][1] * v[j][1]) + (v[j][2] * v[j][2] + v[j][3] * v[j][3]); }
    const float rstd = 1.f / sqrtf(wave_sum(s2, lane) * (1.f / DM) + LN_EPS);
#pragma unroll
    for (int j = 0; j < 4; ++j) { const f32x4 gg = *(const f32x4*)(g + 4 * lane + 256 * j), bb = *(const f32x4*)(bta + 4 * lane + 256 * j); v[j] = v[j] * rstd * gg + bb; }
}

__device__ __forceinline__ void phase_ln_router(const Frame& F, const bf16_t* pre, const float* g, const float* bta, bf16_t* x1b, unsigned char* x1f8,
                                                const float* wr  , const float* br, unsigned* gcnt, unsigned* ltok, float* lgate, int* toke, int* tokp) {
    LAS unsigned char* WH = F.lds + RING_OFF; LAS unsigned char* WL = WH + 65536;
    LAS int* lcnt = (LAS int*)(F.lds + LC_LCNT); LAS int* gbase = lcnt + 32;
    LAS float* lg = (LAS float*)(F.lds + LC_TOKC) + F.wave * (16 * 36);
    LAS int* ent_e = (LAS int*)(F.lds + LC_ENT); LAS int* ent_p = ent_e + 512; LAS float* ent_g = (LAS float*)(ent_p + 512);
    LAS float* part = (LAS float*)(F.lds + LC_ENT);
    LAS float* sE = (LAS float*)(F.lds + LC_LOG); LAS float* cE = sE + 32;
    LAS float* stats = (LAS float*)(F.lds + LC_WSF) + F.wave * 32;
    __syncthreads();
    float sp = 0.f, cp = 0.f;
#pragma unroll 1
    for (int it = 0; it < (DM * NEXP) / (NWAVES * 64 * 16); ++it) { float wv[16], gv[16], bv[16];
#pragma unroll
        for (int j = 0; j < 16; ++j) { const int idx = F.tid + (it * 16 + j) * (NWAVES * 64); wv[j] = wr[idx]; gv[j] = g[idx >> 5]; bv[j] = bta[idx >> 5]; }
#pragma unroll
        for (int j = 0; j < 16; ++j) { const int idx = F.tid + (it * 16 + j) * (NWAVES * 64); const int d = idx >> 5, e = idx & 31; const float w = wv[j] * gv[j];
            const unsigned hb = cvt_pk_bf16(w, 0.f) & 0xffffu; const float wl = w - __uint_as_float(hb << 16); const unsigned lb = cvt_pk_bf16(wl, 0.f) & 0xffffu;
            sp += __uint_as_float(hb << 16) + __uint_as_float(lb << 16); cp += bv[j] * wv[j];
            const int off = e * 2048 + ((((d >> 3) ^ (e & 7))) << 4) + (d & 7) * 2;
            *(LAS unsigned short*)(WH + off) = (unsigned short)hb; *(LAS unsigned short*)(WL + off) = (unsigned short)lb; } }
    part[(F.tid >> 5) * 32 + (F.tid & 31)] = sp; part[512 + (F.tid >> 5) * 32 + (F.tid & 31)] = cp;
    __syncthreads();
    if (F.tid < 32) { float a = 0.f, c = 0.f;
#pragma unroll
        for (int i = 0; i < 16; ++i) { a += part[i * 32 + F.tid]; c += part[512 + i * 32 + F.tid]; }
        sE[F.tid] = a; cE[F.tid] = c + br[F.tid]; }
    __syncthreads();
    const int lane = F.lane;
    const int mrow = lane & 15, kq = lane >> 4;
    for (int chunk = F.bid; chunk < NTOK / 128; chunk += F.G) {
        __syncthreads();
        if (F.tid < 32) lcnt[F.tid] = 0;
        __syncthreads();
        const size_t row0 = (size_t)chunk * 128 + F.wave * 16;
        f32x4 gg[4], bb[4];
#pragma unroll
        for (int j = 0; j < 4; ++j) { gg[j] = *(const f32x4*)(g + 4 * lane + 256 * j); bb[j] = *(const f32x4*)(bta + 4 * lane + 256 * j); }
#pragma unroll 1
        for (int rb = 0; rb < 16; rb += 8) {
            u32x2 raw[8][4];
#pragma unroll
            for (int r = 0; r < 8; ++r)
#pragma unroll
                for (int j = 0; j < 4; ++j) raw[r][j] = *(const u32x2*)(pre + (row0 + rb + r) * DM + 4 * lane + 256 * j);
#pragma unroll
            for (int r = 0; r < 8; ++r) { const size_t row = row0 + rb + r;
                f32x4 v[4];
#pragma unroll
                for (int j = 0; j < 4; ++j) v[j] = (f32x4){bf_lo(raw[r][j].x), bf_hi(raw[r][j].x), bf_lo(raw[r][j].y), bf_hi(raw[r][j].y)};
                float mean_, rstd_;
                ln_row_stats(v, gg, bb, lane, mean_, rstd_);
                if (lane == 0) { stats[2 * (rb + r)] = mean_; stats[2 * (rb + r) + 1] = rstd_; }
#pragma unroll
                for (int j = 0; j < 4; ++j) {
                    u32x2 w; w.x = cvt_pk_bf16(v[j][0], v[j][1]); w.y = cvt_pk_bf16(v[j][2], v[j][3]); *(u32x2*)(x1b + row * DM + 4 * lane + 256 * j) = w;
                    *(unsigned*)(x1f8 + row * DM + 4 * lane + 256 * j) = pk4_fp8(v[j][0] * 4.0f, v[j][1] * 4.0f, v[j][2] * 4.0f, v[j][3] * 4.0f); }
            }
        }
        f32x4 lacc[2] = {(f32x4){0.f, 0.f, 0.f, 0.f}, (f32x4){0.f, 0.f, 0.f, 0.f}};
        const bf16_t* xp = pre + (row0 + mrow) * DM + kq * 8;
#pragma unroll 8
        for (int ks = 0; ks < 32; ++ks) {
            const bf16x8 ah = *(const bf16x8*)(xp + ks * 32);
#pragma unroll
            for (int nb = 0; nb < 2; ++nb) { const int e = nb * 16 + mrow; const int off = e * 2048 + (((ks * 4 + kq) ^ (e & 7)) << 4);
                const bf16x8 bh = *(const LAS bf16x8*)(WH + off), bl = *(const LAS bf16x8*)(WL + off);
                lacc[nb] = __builtin_amdgcn_mfma_f32_16x16x32_bf16(ah, bh, lacc[nb], 0, 0, 0);
                lacc[nb] = __builtin_amdgcn_mfma_f32_16x16x32_bf16(ah, bl, lacc[nb], 0, 0, 0); }
        }
        LDS_WAIT(); asm volatile("" ::: "memory");
#pragma unroll
        for (int nb = 0; nb < 2; ++nb) { const float se_ = sE[nb * 16 + mrow], ce_ = cE[nb * 16 + mrow];
#pragma unroll
            for (int r = 0; r < 4; ++r) { const float mean_ = stats[2 * (4 * kq + r)], rstd_ = stats[2 * (4 * kq + r) + 1];
                lg[(4 * kq + r) * 36 + nb * 16 + mrow] = rstd_ * (lacc[nb][r] - mean_ * se_) + ce_; } }
        LDS_WAIT(); asm volatile("" ::: "memory");
        if (lane < 16) {
            const int rl = F.wave * 16 + lane;
            float lv[32];
#pragma unroll
            for (int c = 0; c < 8; ++c) { const f32x4 t = *(const LAS f32x4*)(lg + lane * 36 + 4 * c); lv[4 * c] = t[0]; lv[4 * c + 1] = t[1]; lv[4 * c + 2] = t[2]; lv[4 * c + 3] = t[3]; }
            float tv[4]; int ti[4];
#pragma unroll
            for (int k = 0; k < 4; ++k) { float best = -INFINITY; int bi = 0;
#pragma unroll
                for (int e = 0; e < 32; ++e) { const bool gt = lv[e] > best; best = gt ? lv[e] : best; bi = gt ? e : bi; }
                tv[k] = best; ti[k] = bi;
#pragma unroll
                for (int e = 0; e < 32; ++e) lv[e] = (e == bi) ? -INFINITY : lv[e]; }
            const float e1 = __expf(tv[1] - tv[0]), e2 = __expf(tv[2] - tv[0]), e3 = __expf(tv[3] - tv[0]); const float inv = 1.0f / (1.0f + e1 + e2 + e3);
            const float gk[4] = {inv, e1 * inv, e2 * inv, e3 * inv};
#pragma unroll
            for (int k = 0; k < 4; ++k) { const int lp = atomicAdd((int*)(lcnt + ti[k]), 1); ent_e[rl * 4 + k] = ti[k]; ent_p[rl * 4 + k] = lp; ent_g[rl * 4 + k] = gk[k]; }
        }
        __syncthreads();
        if (F.tid < 32) gbase[F.tid] = (int)__hip_atomic_fetch_add(gcnt + 64 * F.tid, (unsigned)lcnt[F.tid], RLX_AGENT);
        __syncthreads();
        { const int idx = F.tid; const int e = ent_e[idx], pos = gbase[e] + ent_p[idx]; const int tk = chunk * 512 + idx;
            ltok[(size_t)e * LIST_CAP + pos] = (unsigned)tk; lgate[(size_t)e * LIST_CAP + pos] = ent_g[idx]; toke[tk] = e; tokp[tk] = pos; }
    }
    __syncthreads();
}

__device__ __forceinline__ void phase_combine_ln(const Frame& F, const bf16_t* __restrict__ pre, const unsigned char* __restrict__ Y, const int* __restrict__ toke, const int* __restrict__ tokp,
                                                 const float* __restrict__ g, const float* __restrict__ bta, float* __restrict__ xo, bf16_t* __restrict__ xob, unsigned char* __restrict__ xob8) {
    const LAS int* offs = (const LAS int*)(F.lds + LC_OFFS);
    const int gw = F.bid * NWAVES + F.wave, NGW = F.G * NWAVES, lane = F.lane;
    f32x4 gg[4], bb[4];
#pragma unroll
    for (int j = 0; j < 4; ++j) { gg[j] = *(const f32x4*)(g + 16 * lane + 4 * j); bb[j] = *(const f32x4*)(bta + 16 * lane + 4 * j); }
    i32x4 te[2], tp[2];
#pragma unroll
    for (int q = 0; q < 2; ++q) { const int r = (gw + q * NGW < NTOK) ? gw + q * NGW : (gw < NTOK ? gw : 0); te[q] = *(const i32x4*)(toke + (size_t)r * 4); tp[q] = *(const i32x4*)(tokp + (size_t)r * 4); }
    for (int row0 = gw; row0 < NTOK; row0 += 2 * NGW) {
        const int rows[2] = {row0, row0 + NGW}; const bool ok1 = rows[1] < NTOK;
        u32x4 pv[2][2], yv[2][4];
#pragma unroll
        for (int q = 0; q < 2; ++q) { const int r = (q == 0 || ok1) ? rows[q] : rows[0];
            pv[q][0] = *(const u32x4*)(pre + (size_t)r * DM + 16 * lane); pv[q][1] = *(const u32x4*)(pre + (size_t)r * DM + 16 * lane + 8);
#pragma unroll
            for (int k = 0; k < 4; ++k) { const size_t slot = (size_t)(offs[te[q][k]] + tp[q][k]); yv[q][k] = *(const u32x4*)(Y + slot * DM + 16 * lane); } }
#pragma unroll
        for (int q = 0; q < 2; ++q) { const int rn = row0 + 2 * NGW + q * NGW; const int r = rn < NTOK ? rn : row0; te[q] = *(const i32x4*)(toke + (size_t)r * 4); tp[q] = *(const i32x4*)(tokp + (size_t)r * 4); }
#pragma unroll
        for (int q = 0; q < 2; ++q) { if (q == 1 && !ok1) break; const int row = rows[q];
            f32x4 v[4];
#pragma unroll
            for (int j = 0; j < 4; ++j) { const unsigned p0 = pv[q][j >> 1][(j & 1) * 2], p1 = pv[q][j >> 1][(j & 1) * 2 + 1];
                f32x4 ys = (f32x4){0.f, 0.f, 0.f, 0.f};
#pragma unroll
                for (int k = 0; k < 4; ++k) { const int yw = (int)yv[q][k][j]; const auto lo = __builtin_amdgcn_cvt_pk_f32_fp8(yw, false), hi = __builtin_amdgcn_cvt_pk_f32_fp8(yw, true);
                    ys[0] += lo[0]; ys[1] += lo[1]; ys[2] += hi[0]; ys[3] += hi[1]; }
                v[j] = (f32x4){bf_lo(p0), bf_hi(p0), bf_lo(p1), bf_hi(p1)} + ys * (1.0f / moe::YSC); }
            ln_row_pre(v, gg, bb, lane);
#pragma unroll
            for (int j = 0; j < 4; ++j) if (xo) *(f32x4*)(xo + (size_t)row * DM + 16 * lane + 4 * j) = v[j];
            if (!xo) {
#pragma unroll
                for (int h = 0; h < 2; ++h) { u32x4 w; w.x = cvt_pk_bf16(v[2 * h][0], v[2 * h][1]); w.y = cvt_pk_bf16(v[2 * h][2], v[2 * h][3]); w.z = cvt_pk_bf16(v[2 * h + 1][0], v[2 * h + 1][1]); w.w = cvt_pk_bf16(v[2 * h + 1][2], v[2 * h + 1][3]);
                    *(u32x4*)(xob + (size_t)row * DM + 16 * lane + 8 * h) = w; }
                u32x4 w8;
#pragma unroll
                for (int j = 0; j < 4; ++j) w8[j] = pk4_fp8(v[j][0] * XIN_SC, v[j][1] * XIN_SC, v[j][2] * XIN_SC, v[j][3] * XIN_SC);
                *(u32x4*)(xob8 + (size_t)row * DM + 16 * lane) = w8; } }
    }
}

struct KArgs { const float* in[26]; float* out; unsigned char* ws; int ph_lo, ph_hi; };
typedef const __attribute__((address_space(4))) KArgs* KAP;
#define KA() ({ KAP p_ = (KAP)__builtin_amdgcn_kernarg_segment_ptr(); asm volatile("" : "+s"(p_)); p_; })
#define KIN(k) ((const float*)ka->in[k])
#define WSP(T, off) ((T*)(ka->ws + (off)))

struct BgStage {
    static constexpr int BG_T = 4, EVERY = 2;
    static constexpr int T_GU = NEXP * (DM / 128) * (2 * DM / 32), T_DN = NEXP * (DM / 128) * (DM / 32), T_PG = (DM / 128) * (DM / 32), T_AB = 2 * T_PG, TOTAL = (T_GU + T_DN + T_PG + T_AB) / (8 * BG_T);
    static_assert(T_GU % (8 * BG_T) == 0 && T_DN % (8 * BG_T) == 0 && T_PG % (8 * BG_T) == 0 && T_AB % (8 * BG_T) == 0 && BG_T % 2 == 0, "block-items do not straddle the two weight stacks");
    unsigned* ctr; int layer;
    struct Tile { const float* W; unsigned char* WT; int N, k0, n0; float sc; };
    __device__ __forceinline__ Tile tile(KAP ka, int t) const { Tile r;
        if (t < T_GU) { const int mi = layer * NEXP + (t >> 9), q = t & 511; r.W = KIN(18) + (size_t)mi * DM * 2 * DM; r.WT = WSP(unsigned char, WS_WGU) + (size_t)mi * DM * 2 * DM; r.N = 2 * DM; r.k0 = (q >> 6) * 128; r.n0 = (q & 63) * 32; r.sc = moe::WGUSC; }
        else if (t >= T_GU + T_DN + T_PG) { const int t3 = t - T_GU - T_DN - T_PG, w_ = t3 >> 8, q = t3 & 255;
            r.W = KIN(10 + w_) + (size_t)layer * DM * DM; r.WT = WSP(unsigned char, w_ ? WS_WB : WS_WA) + (size_t)layer * DM * DM; r.N = DM; r.k0 = (q >> 5) * 128; r.n0 = (q & 31) * 32; r.sc = WAB_SC; }
        else if (t >= T_GU + T_DN) { const int q = t - T_GU - T_DN; r.W = KIN(22) + (size_t)layer * DM * DM; r.WT = WSP(unsigned char, WS_WPG8) + (size_t)layer * DM * DM; r.N = DM; r.k0 = (q >> 5) * 128; r.n0 = (q & 31) * 32; r.sc = WPGSC; }
        else { const int t2 = t - T_GU, mi = layer * NEXP + (t2 >> 8), q = t2 & 255; r.W = KIN(20) + (size_t)mi * DM * DM; r.WT = WSP(unsigned char, WS_WDN) + (size_t)mi * DM * DM; r.N = DM; r.k0 = (q >> 5) * 128; r.n0 = (q & 31) * 32; r.sc = moe::WDNSC; }
        return r; }
    __device__ __forceinline__ void operator()(int bi, LAS unsigned char*, int wave) const {
        int l_; asm volatile("v_mbcnt_lo_u32_b32 %0, -1, 0\n\tv_mbcnt_hi_u32_b32 %0, -1, %0" : "=v"(l_));
        KAP ka = KA();
        const int t0 = bi * (8 * BG_T) + wave;
        float va[64], vb[64];
        Tile ta = tile(ka, t0), tb;
        bg_tile_load(va, ta.W, ta.N, ta.k0, ta.n0, l_);
#pragma unroll
        for (int s_ = 1; s_ < BG_T; s_ += 2) {
            tb = tile(ka, t0 + 8 * s_);
            bg_tile_load(vb, tb.W, tb.N, tb.k0, tb.n0, l_);
            bg_tile_store(va, ta.WT, DM, ta.k0, ta.n0, l_, ta.sc);
            if (s_ + 1 < BG_T) { ta = tile(ka, t0 + 8 * (s_ + 1)); bg_tile_load(va, ta.W, ta.N, ta.k0, ta.n0, l_); }
            bg_tile_store(vb, tb.WT, DM, tb.k0, tb.n0, l_, tb.sc);
        }
    }
};

constexpr int NPH_LAYER = 9, NPHASES = 1 + DEPTH * NPH_LAYER;
__global__ void __launch_bounds__(NWAVES * 64, 2) mk_fwd(KArgs args) {
    extern __shared__ __attribute__((aligned(16))) unsigned char lds_raw[];
    Frame F; F.lds = (LAS unsigned char*)lds_raw; F.tid = threadIdx.x; F.lane = F.tid & 63; F.wave = __builtin_amdgcn_readfirstlane(F.tid >> 6); F.G = gridDim.x; F.bid = blockIdx.x;
    const int wave0 = F.wave;
#define REFRAME() do { int l_; asm volatile("v_mbcnt_lo_u32_b32 %0, -1, 0\n\tv_mbcnt_hi_u32_b32 %0, -1, %0" : "=v"(l_)); int w_ = wave0; asm volatile("" : "+s"(w_)); \
        F.lane = l_; F.wave = w_; F.tid = w_ * 64 + l_; int b_ = blockIdx.x; asm volatile("" : "+s"(b_)); F.bid = b_; } while (0)
    F.ctl = (unsigned*)(args.ws + WS_CTL);
    volatile LAS unsigned* MISC = (volatile LAS unsigned*)(F.lds + LC_MISC);
    if (F.tid < 64) MISC[F.tid] = 0u;
    __syncthreads();
    XcdBarrier bar; bar.bar = F.ctl + CW_BAR; bar.x = 0; bar.st = nullptr;
    if (MK_N_LAUNCHES == 1) bar = xcd_barrier_post(F.ctl + CW_BAR, MISC + 8);
    const int lo = args.ph_lo, hi = args.ph_hi;
#ifndef PH_MASK
#define PH_MASK 0x3ff
#endif
#define PON(id) (((PH_MASK) >> (id)) & 1)
#define IN(k) (lo <= (k) && (k) < hi)
#define SEAM(k) do { if (IN(k) && IN((k) + 1)) xcd_barrier(bar); } while (0)
#ifdef DOUBLE_PHASE
#define NREP(k) (((k) == DOUBLE_PHASE) ? 2 : 1)
#else
#define NREP(k) 1
#endif
#define PHASE_LOOP(k) for (int rep = 0; rep < NREP(k); ++rep)
#define PHASE_REDO(k) do { if (rep + 1 < NREP(k)) xcd_barrier(bar); } while (0)
    if (PON(0) && IN(0)) PHASE_LOOP(0) { REFRAME();
        LAS float* scr = (LAS float*)(F.lds + RING_OFF + F.wave * 16384);
        { KAP ka = KA(); p0_transpose_stack(F, KIN(2), WSP(bf16_t, WS_WIN), DEPTH, DM, INW, scr); }
        { KAP ka = KA(); p0_transpose_stack(F, KIN(12), WSP(bf16_t, WS_WOUT), DEPTH, DM, DM, scr); }
        { KAP ka = KA(); p0_transpose_stack(F, KIN(23), WSP(bf16_t, WS_WPP), DEPTH, PLED, DM, scr); }
        { KAP ka = KA(); cvt_rows_bf16(F, KIN(0), WSP(bf16_t, WS_XB), (size_t)NTOK * DM, WSP(unsigned char, WS_XB8)); }
        { KAP ka = KA();
          for (int t = F.bid * NWAVES + F.wave; t < DEPTH * 512; t += F.G * NWAVES) { const int ly = t >> 9, q = t & 511, k0 = (q >> 6) * 128, n0 = (q & 63) * 32;
              float vt[64]; bg_tile_load(vt, KIN(2) + (size_t)ly * DM * INW + NT_PROJ * 256, INW, k0, n0, F.lane);
              bg_tile_store(vt, WSP(unsigned char, WS_WIN8) + (size_t)ly * 2048 * DM, DM, k0, n0, F.lane, WING_SC); } }
        { KAP ka = KA(); cvt_rows_bf16(F, KIN(1), WSP(bf16_t, WS_PB), (size_t)DEPTH * NTOK * PLED); }
        VM_WAIT(); __syncthreads(); PHASE_REDO(0);
    }
    SEAM(0);

#pragma unroll 1
    for (int layer = 0; layer < DEPTH; ++layer) {
        const int pb = 1 + layer * NPH_LAYER;
        unsigned* gcnt = F.ctl + CW_CNT + layer * NEXP * 64;
        if (PON(1) && IN(pb + 0)) PHASE_LOOP(pb + 0) { REFRAME();
            { KAP ka = KA(); pg8::DenseSched S; S.init(WSP(bf16_t, WS_XB), WSP(bf16_t, WS_WIN) + (size_t)layer * INW * DM, NTOK, NT_PROJ * 256, DM, F.G, F.bid);
              pg8::EpiProj E{WSP(bf16_t, WS_PROJ), INW, KIN(3) + (size_t)layer * INW, true, F.ctl + CW_KMAX + layer * 64, WSP(bf16_t, WS_KIMG), WSP(bf16_t, WS_VIMG), 0};
              pg8::gemm_phase<pg8::EpiProj, pg8::DenseSched>(F.lds + RING_OFF, DM, S, E, F.tid); }
            REFRAME();
            { KAP ka = KA(); pg8::DenseSchedF8in S; S.init(WSP(unsigned char, WS_XB8), WSP(unsigned char, WS_WIN8) + (size_t)layer * 2048 * DM, NTOK, NT_GATE * 256, DM / 2, F.G, F.bid);
              { constexpr int NU = (NTOK / 256) * NT_PROJ, NF = (NTOK / 256) * NT_GATE; const int rem = NU % F.G, num = NF - 2 * (F.G - rem);
                if (rem != 0 && num >= 0 && num % F.G == 0 && (rem % 8) == 0) { S.nl = rem; S.cntL = num / F.G; S.cntS = S.cntL + 2; } }
              pg8::EpiProj E{WSP(bf16_t, WS_PROJ), INW, KIN(3) + (size_t)layer * INW, false, nullptr, nullptr, nullptr, NT_PROJ};
              pg8::gemm_phase<pg8::EpiProj, pg8::DenseSchedF8in, true, true>(F.lds + RING_OFF, DM / 2, S, E, F.tid); }
            REFRAME();
            { KAP ka = KA(); pg8::DenseSched S; S.init(WSP(bf16_t, WS_PB) + (size_t)layer * NTOK * PLED, WSP(bf16_t, WS_WPP) + (size_t)layer * DM * PLED, NTOK, DM, PLED, F.G, F.bid);
              pg8::EpiProj E{WSP(bf16_t, WS_TPP), DM, nullptr, false, nullptr, nullptr, nullptr, 0};
              pg8::gemm_phase<pg8::EpiProj, pg8::DenseSched>(F.lds + RING_OFF, PLED, S, E, F.tid); }
        PHASE_REDO(pb + 0); }
        SEAM(pb + 0);
        if (PON(2) && IN(pb + 1)) PHASE_LOOP(pb + 1) { REFRAME();
            const float lam_init = layer == 0 ? 0.2f : 0.35550906759096926f;
            { KAP ka = KA();
              float d1 = KIN(4)[layer * 64 + F.lane] * KIN(5)[layer * 64 + F.lane], d2 = KIN(6)[layer * 64 + F.lane] * KIN(7)[layer * 64 + F.lane];
              d1 = wave_sum(d1, F.lane); d2 = wave_sum(d2, F.lane);
              float lam, osc;
              { const float lv_ = __expf(d1) - __expf(d2) + lam_init, ov_ = 1.0f - lam_init; unsigned ls_, os_;
                asm volatile("s_nop 7\n\tv_readfirstlane_b32 %0, %2\n\tv_readfirstlane_b32 %1, %3\n\ts_nop 7" : "=&s"(ls_), "=&s"(os_) : "v"(lv_), "v"(ov_)); lam = __uint_as_float(ls_); osc = __uint_as_float(os_); }
              att::Args A{WSP(bf16_t, WS_PROJ), WSP(unsigned char, WS_OD), KIN(8) + layer * 128, KIN(9) + layer * 16, lam, osc, F.ctl + CW_KMAX + layer * 64, WSP(bf16_t, WS_KIMG), WSP(bf16_t, WS_VIMG)};
              att::attn_phase<false>(A, F.ctl + CW_QX + (layer * 2 + rep) * 512, NBATCH * 8 * (SEQ / 128), F.lds, F.wave, BgStage{F.ctl + CW_BG + layer * 64, layer}, F.bid, true); }
            REFRAME();
            { KAP ka = KA();
              int bgoff_ = 0; asm volatile("" : "+s"(bgoff_));
              att::Args B{WSP(bf16_t, WS_PROJ), WSP(unsigned char, WS_OS), KIN(8) + layer * 128, KIN(9) + layer * 16, 0.f, 1.0f, F.ctl + CW_KMAX + layer * 64, nullptr, nullptr};
              att::attn_phase<true>(B, F.ctl + CW_Q + (layer * 2 + 1) * 64 + rep * 16, NBATCH * 2 * 4 * (SEQ / 128), F.lds, F.wave, BgStage{F.ctl + CW_BG + layer * 64, layer}, F.bid, bgoff_ != 0);
              att::bg_drain(F.lds, F.wave, BgStage{F.ctl + CW_BG + layer * 64, layer}); }
        PHASE_REDO(pb + 1); }
        SEAM(pb + 1);
        if (PON(3) && IN(pb + 2)) PHASE_LOOP(pb + 2) { REFRAME();
            { KAP ka = KA(); pg8::DenseSchedF8in S; S.init(WSP(unsigned char, WS_OD), WSP(unsigned char, WS_WA) + (size_t)layer * DM * DM, NTOK, DM, DM / 2, F.G, F.bid);
              pg8::EpiGate<false> E{WSP(bf16_t, WS_MG), WSP(bf16_t, WS_PROJ), COL_GA};
              pg8::gemm_phase<pg8::EpiGate<false>, pg8::DenseSchedF8in, true, true>(F.lds + RING_OFF, DM / 2, S, E, F.tid); }
            VM_WAIT(); REFRAME();
            { KAP ka = KA(); pg8::DenseSchedF8in S; S.init(WSP(unsigned char, WS_OS), WSP(unsigned char, WS_WB) + (size_t)layer * DM * DM, NTOK, DM, DM / 2, F.G, F.bid);
              pg8::EpiGate<true> E{WSP(bf16_t, WS_MG), WSP(bf16_t, WS_PROJ), COL_GB};
              pg8::gemm_phase<pg8::EpiGate<true>, pg8::DenseSchedF8in, true, true>(F.lds + RING_OFF, DM / 2, S, E, F.tid); }
        PHASE_REDO(pb + 2); }
        SEAM(pb + 2);
        if (PON(4) && IN(pb + 3)) PHASE_LOOP(pb + 3) { REFRAME();
            KAP ka = KA(); pg8::DenseSched S; S.init(WSP(bf16_t, WS_MG), WSP(bf16_t, WS_WOUT) + (size_t)layer * DM * DM, NTOK, DM, DM, F.G, F.bid);
            pg8::EpiRes E{KIN(0), (layer == 0) ? (const bf16_t*)nullptr : (const bf16_t*)WSP(bf16_t, WS_XB), WSP(bf16_t, WS_PRE), KIN(13) + layer * DM};
            pg8::gemm_phase<pg8::EpiRes, pg8::DenseSched>(F.lds + RING_OFF, DM, S, E, F.tid);
        PHASE_REDO(pb + 3); }
        SEAM(pb + 3);
        if (PON(5) && IN(pb + 4)) PHASE_LOOP(pb + 4) { REFRAME();
            KAP ka = KA();
            const bool dummy = rep + 1 < NREP(pb + 4);
            phase_ln_router(F, WSP(bf16_t, WS_PRE), KIN(14) + layer * DM, KIN(15) + layer * DM, WSP(bf16_t, WS_X1B), WSP(unsigned char, WS_X1F8), KIN(16) + (size_t)layer * DM * NEXP, KIN(17) + layer * NEXP, dummy ? F.ctl + 65536 : gcnt,
                            WSP(unsigned, dummy ? WS_Y : WS_LTOK), WSP(float, dummy ? WS_Y + 8 * MiB : WS_LGATE), WSP(int, dummy ? WS_Y + 16 * MiB : WS_TOKE), WSP(int, dummy ? WS_Y + 24 * MiB : WS_TOKP));
        PHASE_REDO(pb + 4); }
        SEAM(pb + 4);
        if (PON(6) && IN(pb + 5)) PHASE_LOOP(pb + 5) { REFRAME();
            moe_tables(F, gcnt);
            KAP ka = KA(); const unsigned* LTOK = WSP(unsigned, WS_LTOK);
            moe::Tables T;
            const int total = T.mts[NEXP] * 8;
            LAS unsigned* tokc = (LAS unsigned*)(F.lds + LC_TOKC);
#pragma unroll 1
            for (int i0 = 0; i0 < 20; i0 += 10) { unsigned tk[10];
#pragma unroll
                for (int q = 0; q < 10; ++q) { int mt, pn_; const bool ok = moe::Sched1::map(i0 + q, F.G, F.bid, total, mt, pn_); tk[q] = 0u;
                    if (ok && F.tid < 256) { const int e = moe::find_expert(T, mt); const int pos = mt * 256 + F.tid - T.offs[e]; if (pos < T.cnt[e]) tk[q] = LTOK[(unsigned)(e * LIST_CAP + pos)]; } }
#pragma unroll
                for (int q = 0; q < 10; ++q) if (F.tid < 256) tokc[(i0 + q) * 256 + F.tid] = tk[q] >> 2; }
            __syncthreads();
            moe::Sched1 S{T, (const char*)WSP(unsigned char, WS_X1F8), (const char*)(WSP(unsigned char, WS_WGU) + (size_t)layer * NEXP * 2048 * DM), tokc, F.G, F.bid, total};
            moe::EpiAct E{WSP(unsigned char, WS_ACT), KIN(19) + (size_t)layer * NEXP * 2048};
            pg8::gemm_phase<moe::EpiAct, moe::Sched1, true, true>(F.lds + RING_OFF, DM / 2, S, E, F.tid);
        PHASE_REDO(pb + 5); }
        SEAM(pb + 5);
        if (PON(7) && IN(pb + 6)) PHASE_LOOP(pb + 6) { REFRAME();
            if (MK_N_LAUNCHES != 1) moe_tables(F, gcnt);
            moe::Tables T;
            KAP ka = KA();
            moe::Sched2 S{T, (const char*)WSP(unsigned char, WS_ACT), (const char*)(WSP(unsigned char, WS_WDN) + (size_t)layer * NEXP * DM * DM), F.G >> 2, (F.G >> 5) * (F.bid & 7) + (F.bid >> 5), T.mts[NEXP], (F.bid >> 3) & 3};
            moe::EpiY E{WSP(unsigned char, WS_Y), KIN(21) + (size_t)layer * NEXP * DM, WSP(float, WS_LGATE), T};
            pg8::gemm_phase<moe::EpiY, moe::Sched2, true, true>(F.lds + RING_OFF, DM / 2, S, E, F.tid);
        PHASE_REDO(pb + 6); }
        if (PON(8) && IN(pb + 7)) PHASE_LOOP(pb + 7) { REFRAME();
            KAP ka = KA(); pg8::DenseSchedF8 S; S.init(WSP(unsigned char, WS_X1F8), WSP(unsigned char, WS_WPG8) + (size_t)layer * DM * DM, NTOK, DM, DM / 2, F.G, F.bid);
            pg8::EpiPle E{WSP(bf16_t, WS_X1B), WSP(bf16_t, WS_PRE), WSP(bf16_t, WS_TPP)};
            pg8::gemm_phase<pg8::EpiPle, pg8::DenseSchedF8, true, true>(F.lds + RING_OFF, DM / 2, S, E, F.tid);
        PHASE_REDO(pb + 7); }
        SEAM(pb + 7);
        if (PON(9) && IN(pb + 8)) PHASE_LOOP(pb + 8) { REFRAME();
            if (MK_N_LAUNCHES != 1) moe_tables(F, gcnt);
            KAP ka = KA();
            phase_combine_ln(F, WSP(bf16_t, WS_PRE), WSP(unsigned char, WS_Y), WSP(int, WS_TOKE), WSP(int, WS_TOKP), KIN(24) + layer * DM, KIN(25) + layer * DM, (layer + 1 == DEPTH) ? ka->out : (float*)nullptr, WSP(bf16_t, WS_XB), WSP(unsigned char, WS_XB8));
            VM_WAIT(); __syncthreads(); PHASE_REDO(pb + 8);
        }
        if (layer + 1 < DEPTH) SEAM(pb + 8);
    }

#undef IN
#undef SEAM
}

extern "C" void kernel_launch(void* const* d_in, const int* in_sizes, int n_in, void* d_out, int out_size, void* d_ws, size_t ws_size, hipStream_t stream) {
    static int grid = 0;
    if (grid == 0) {
        if (n_in != 26 || out_size != NTOK * DM || ws_size < WS_END) { fprintf(stderr, "kernel_launch: unexpected shapes (n_in %d, out %d, ws %zu)\n", n_in, out_size, ws_size); grid = -1; return; }
        int dev = 0, cus = 0, per_cu = 0;
        if (hipGetDevice(&dev) != hipSuccess || hipDeviceGetAttribute(&cus, hipDeviceAttributeMultiprocessorCount, dev) != hipSuccess) { grid = -1; return; }
        if (hipFuncSetAttribute((const void*)mk_fwd, hipFuncAttributeMaxDynamicSharedMemorySize, LDS_BYTES) != hipSuccess) { fprintf(stderr, "kernel_launch: hipFuncSetAttribute failed\n"); grid = -1; return; }
        if (hipOccupancyMaxActiveBlocksPerMultiprocessor(&per_cu, (const void*)mk_fwd, NWAVES * 64, LDS_BYTES) != hipSuccess || per_cu < 1) { fprintf(stderr, "kernel_launch: occupancy query says %d\n", per_cu); }
        (void)hipGetLastError();
        grid = cus - cus % 32;
    }
    if (grid < 0) return;
    if (hipMemsetAsync((char*)d_ws + WS_CTL, 0, CTL_ZERO_BYTES, stream) != hipSuccess) return;
    KArgs a{};
    for (int i = 0; i < 26; ++i) a.in[i] = (const float*)d_in[i];
    a.out = (float*)d_out; a.ws = (unsigned char*)d_ws;
    if (MK_N_LAUNCHES == 1) {
        a.ph_lo = 0; a.ph_hi = NPHASES;
        hipLaunchKernelGGL(mk_fwd, dim3(grid), dim3(NWAVES * 64), LDS_BYTES, stream, a);
    } else {
        for (int ph = 0; ph < NPHASES; ++ph) { a.ph_lo = ph; a.ph_hi = ph + 1; hipLaunchKernelGGL(mk_fwd, dim3(grid), dim3(NWAVES * 64), LDS_BYTES, stream, a); }
    }
}
```

```cpp
#include <hip/hip_runtime.h>
#include <cstdio>
#include <cstdint>

#ifndef MK_N_LAUNCHES
#define MK_N_LAUNCHES 1
#endif

#define GAS __attribute__((address_space(1)))
#define LAS __attribute__((address_space(3)))
typedef unsigned short bf16_t;
typedef short bf16x8 __attribute__((ext_vector_type(8)));
typedef short s16x4 __attribute__((ext_vector_type(4)));
typedef float f32x4 __attribute__((ext_vector_type(4)));
typedef float f32x2 __attribute__((ext_vector_type(2)));
typedef float f32x16 __attribute__((ext_vector_type(16)));
typedef unsigned u32x4 __attribute__((ext_vector_type(4)));
typedef unsigned u32x2 __attribute__((ext_vector_type(2)));
typedef int i32x4 __attribute__((ext_vector_type(4)));

constexpr int NBATCH = 2, SEQ = 16384, NTOK = NBATCH * SEQ, DM = 1024, INW = 6400, NEXP = 32, TOPK = 4, PLED = 256, DEPTH = 2;
constexpr int COL_DQ = 0, COL_DK = 1024, COL_DV = 2048, COL_SQ = 3072, COL_SK = 4096, COL_SV = 4224, COL_GA = 4352, COL_GB = 5376;
constexpr float LOG2E = 1.4426950408889634f, QSCALE = 0.125f * LOG2E, DN_ALPHA = 1.4142135623730951f;
constexpr float LN_EPS = 1e-5f, RMS_EPS = 1e-5f;
constexpr int LIST_CAP = NTOK;
constexpr int SLOTS_MAX = 139264;

constexpr size_t MiB = 1u << 20;
constexpr size_t WS_CTL = 0, CTL_ZERO_BYTES = 1 * MiB;
constexpr size_t WS_WIN = 2 * MiB, WS_WA = 27 * MiB, WS_WB = 31 * MiB, WS_WOUT = 35 * MiB, WS_WPG = 39 * MiB, WS_WPP = 43 * MiB;
constexpr size_t WS_WGU = 44 * MiB, WS_WDN = 300 * MiB;
constexpr size_t WS_XB = 428 * MiB, WS_PB = 492 * MiB, WS_PROJ = 524 * MiB, WS_ACT = WS_PROJ  ;
constexpr size_t WS_WIN8 = (1244 + 66) * MiB;
constexpr size_t WS_XB8 = (1244 + 72) * MiB;
constexpr float WING_SC = 32.0f, XIN_SC = 16.0f, ATT_OSC = 16.0f, WAB_SC = 32.0f;
constexpr int NT_PROJ = 17, NT_GATE = 8;
constexpr size_t WS_WPG8 = (1244 + 64) * MiB;
constexpr float WPGSC = 32.0f;
constexpr size_t WS_OD = 924 * MiB, WS_OS = 988 * MiB, WS_MG = 1052 * MiB, WS_PRE = 1116 * MiB, WS_X1 = 1244 * MiB, WS_X1B = 1372 * MiB;
constexpr size_t WS_Y = 1436 * MiB, WS_TPP = 1708 * MiB, WS_LTOK = 1772 * MiB, WS_LGATE = 1776 * MiB, WS_TOKE = 1780 * MiB, WS_TOKP = 1781 * MiB, WS_KIMG = 1782 * MiB, WS_VIMG = 1846 * MiB, WS_X1F8 = 1910 * MiB, WS_END = 1942 * MiB;
static_assert((size_t)SLOTS_MAX * DM * 2 <= 272 * MiB, "act / y size");
constexpr int CW_TMO = 0, CW_CODE = 1, CW_BAR = 4096, CW_Q = 8192, CW_CNT = 12288, CW_KMAX = 20480, CW_QX = 24576, CW_BG = 32768;

constexpr int RING_OFF = 0, RING_BYTES = 131072;
constexpr int LDSCTL_OFF = RING_BYTES;
constexpr int LC_MISC = LDSCTL_OFF;
constexpr int LC_CNT = LDSCTL_OFF + 256;
constexpr int LC_OFFS = LDSCTL_OFF + 512;
constexpr int LC_MTS = LDSCTL_OFF + 768;
constexpr int LC_LCNT = LDSCTL_OFF + 1024;
constexpr int LC_LOG = LDSCTL_OFF + 1536;
constexpr int LC_ENT = LDSCTL_OFF + 2560;
constexpr int LC_WSF = LDSCTL_OFF + 8704;
constexpr int LC_TOKC = LDSCTL_OFF + 10752 + 64;
constexpr int LDS_BYTES = 163840;
static_assert(LC_TOKC + 20 * 256 * 4 <= LDS_BYTES, "LDS map");

#define RLX_AGENT __ATOMIC_RELAXED, __HIP_MEMORY_SCOPE_AGENT
#define LDS_WAIT() asm volatile("s_waitcnt lgkmcnt(0)" ::: "memory")
#define VM_WAIT() asm volatile("s_waitcnt vmcnt(0)" ::: "memory")

__device__ __forceinline__ unsigned cvt_pk_bf16(float lo, float hi) { unsigned r; asm volatile("v_cvt_pk_bf16_f32 %0, %1, %2" : "=v"(r) : "v"(lo), "v"(hi)); return r; }
__device__ __forceinline__ unsigned pk4_fp8(float a, float b, float c, float d) { int w = 0; w = __builtin_amdgcn_cvt_pk_fp8_f32(a, b, w, false); w = __builtin_amdgcn_cvt_pk_fp8_f32(c, d, w, true); return (unsigned)w; }
__device__ __forceinline__ float bf_lo(unsigned u) { return __uint_as_float(u << 16); }
__device__ __forceinline__ float bf_hi(unsigned u) { return __uint_as_float(u & 0xffff0000u); }
__device__ __forceinline__ float sigmoidf_(float x) { return __builtin_amdgcn_rcpf(1.0f + __builtin_amdgcn_exp2f(-x * LOG2E)); }
__device__ __forceinline__ float dpp_xor1(float v) { return __builtin_bit_cast(float, __builtin_amdgcn_update_dpp(0, __builtin_bit_cast(int, v), 0xB1, 0xf, 0xf, true)); }
__device__ __forceinline__ float dpp_xor2(float v) { return __builtin_bit_cast(float, __builtin_amdgcn_update_dpp(0, __builtin_bit_cast(int, v), 0x4E, 0xf, 0xf, true)); }
__device__ __forceinline__ float shx(float v, int m, int lane) { return __builtin_bit_cast(float, __builtin_amdgcn_ds_bpermute((lane ^ m) << 2, __builtin_bit_cast(int, v))); }
__device__ __forceinline__ float wave_sum(float v, int lane) {
#pragma unroll
    for (int o = 1; o < 64; o <<= 1) v += shx(v, o, lane);
    return v;
}

namespace pg8 {
#define PG8_LAS __attribute__((address_space(3)))
constexpr int BM = 256, BK = 64, HALF = 128, HTB = HALF * BK * 2, STAGE_BYTES = 8 * HTB, NXCD = 8, WGM = 8;
__host__ __device__ __forceinline__ int lds_byte(int r, int c) { const int st = (r >> 4) * 2 + (c >> 5), rr = r & 15, cc = c & 31, ob = rr * 64 + cc * 2; return st * 1024 + (ob ^ (((ob >> 9) & 1) << 5)); }
__host__ __device__ __forceinline__ void stage_rc(int b, int& R, int& C) { const int st = b / 1024, sb = b % 1024, swz = sb ^ (((sb >> 9) & 1) << 5); R = (st >> 1) * 16 + swz / 64; C = (st & 1) * 32 + (swz % 64) / 2; }
__host__ __device__ __forceinline__ int perm32(int rho) { const int n = rho >> 4, i = rho & 15; return 8 * (i >> 2) + 4 * n + (i & 3); }

struct Unit { int pm, pn, ex; };

struct DenseSched {
    static constexpr bool UNIT_OFFS = false; static constexpr int SCALE_A = 0x7F7F7F7F, SCALE_B = 0x7F7F7F7F;
    const char* A; const char* Bt; int K; int nM, nN, nwg, G, c;
    __device__ void init(const void* A_, const void* Bt_, int M, int N, int K_, int G_, int c_) { A = (const char*)A_; Bt = (const char*)Bt_; K = K_; nM = M / BM; nN = N / BM; nwg = nM * nN; G = G_; c = c_; }
    __device__ __forceinline__ bool next(int i, Unit& u) const {
        const long L = (long)i * G + c; if (L >= nwg) return false;
        int wgid = (int)L; { const int q = nwg / NXCD, r = nwg % NXCD, xcd = wgid % NXCD, off = wgid / NXCD; wgid = (xcd < r ? xcd * (q + 1) : r * (q + 1) + (xcd - r) * q) + off; }
        const int nig = WGM * nN, gid = wgid / nig, fm = gid * WGM, gsz = (nM - fm) < WGM ? (nM - fm) : WGM;
        u.pm = fm + ((wgid % nig) % gsz); u.pn = (wgid % nig) / gsz; u.ex = 0; return true;
    }
    __device__ __forceinline__ const char* a_base(const Unit& u) const { return A + (size_t)u.pm * BM * K * 2; }
    __device__ __forceinline__ void a_offs(const Unit&, const int (&R)[2], const int (&C)[2], unsigned (&off)[2][2]) const {
#pragma unroll
        for (int h = 0; h < 2; ++h)
#pragma unroll
            for (int i = 0; i < 2; ++i) off[h][i] = (unsigned)((h * HALF + R[i]) * K + C[i]) * 2u;
    }
    __device__ __forceinline__ const char* b_base(const Unit& u, int h) const { return Bt + ((size_t)u.pn * BM + h * HALF) * K * 2; }
};

struct DenseSchedF8 : DenseSched { static constexpr int SCALE_A = 0x7D7D7D7D, SCALE_B = 0x7A7A7A7A; };
struct DenseSchedF8in : DenseSched { static constexpr int SCALE_A = 0x7B7B7B7B, SCALE_B = 0x7A7A7A7A;
    int nl = 0, cntL = 0, cntS = 0;
    __device__ __forceinline__ bool next(int i, Unit& u) const {
        if (nl == 0) return DenseSched::next(i, u);
        int L; if (c < nl) { if (i >= cntL) return false; L = i * nl + c; } else { if (i >= cntS) return false; L = nl * cntL + i * (G - nl) + (c - nl); }
        int wgid = L; { const int q = nwg / NXCD, r = nwg % NXCD, xcd = wgid % NXCD, off = wgid / NXCD; wgid = (xcd < r ? xcd * (q + 1) : r * (q + 1) + (xcd - r) * q) + off; }
        const int nig = WGM * nN, gid = wgid / nig, fm = gid * WGM, gsz = (nM - fm) < WGM ? (nM - fm) : WGM;
        u.pm = fm + ((wgid % nig) % gsz); u.pn = (wgid % nig) / gsz; u.ex = 0; return true;
    }
};
template <class Epi, class Sched, bool ALIGN_EPI = true, bool FP8 = false>
__device__ __forceinline__ void gemm_phase(PG8_LAS unsigned char* lds, const int K, const Sched& S, const Epi& E, const int tid  ) {
    const int wid = __builtin_amdgcn_readfirstlane(tid >> 6), lane = tid & 63, wr = wid >> 2, wc = wid & 3, fr = lane & 15, fq = lane >> 4;
    const int nt = K / BK;
    int R[2], C[2]; unsigned voffB[2];
#pragma unroll
    for (int i = 0; i < 2; ++i) { stage_rc(tid * 16 + i * 8192, R[i], C[i]); const int Rb = Epi::PERM ? ((R[i] & ~31) + perm32(R[i] & 31)) : R[i]; voffB[i] = (unsigned)(Rb * K + C[i]) * 2u; }
    const unsigned kstep = (unsigned)(BK * 2);
    const unsigned ldsw = (unsigned)wid * 1024u;
    const int aoff = lds_byte(wr * 64 + fr, fq * 8), boff = lds_byte(wc * 32 + fr, fq * 8);
#define PG8_SA(b, h) (((b) * 2 + (h)) * HTB)
#define PG8_SB(b, h) ((4 + (b) * 2 + (h)) * HTB)
#define PG8_GLDS(sbase_, voff_, ldsdst_) do { unsigned keep_; asm volatile("s_mov_b32 %0, m0\n\ts_mov_b32 m0, %3\n\ts_nop 0\n\tglobal_load_lds_dwordx4 %1, %2\n\ts_mov_b32 m0, %0" \
        : "=&s"(keep_) : "v"(voff_), "s"(sbase_), "s"(ldsdst_) : "memory"); } while (0)
    const unsigned ldsbase = (unsigned)(uintptr_t)lds + ldsw;
#define PG8_STAGE_A(bufoff, h, base, offs, kb) do { const char* _b = (base) + (kb); _Pragma("unroll") for (int _i = 0; _i < 2; ++_i) \
        PG8_GLDS(_b, (offs)[h][_i], (unsigned)__builtin_amdgcn_readfirstlane(ldsbase + (bufoff) + _i * 8192)); } while (0)
#define PG8_STAGE_B(bufoff, base, kb) do { const char* _b = (base) + (kb); _Pragma("unroll") for (int _i = 0; _i < 2; ++_i) \
        PG8_GLDS(_b, voffB[_i], (unsigned)__builtin_amdgcn_readfirstlane(ldsbase + (bufoff) + _i * 8192)); } while (0)
#define PG8_LDA(dst, b, h) do { _Pragma("unroll") for (int m = 0; m < 4; ++m) _Pragma("unroll") for (int k = 0; k < 2; ++k) dst[m][k] = *(const PG8_LAS bf16x8*)(lds + PG8_SA(b, h) + aoff + m * 2048 + k * 1024); } while (0)
#define PG8_LDB(dst, b, h) do { _Pragma("unroll") for (int n = 0; n < 2; ++n) _Pragma("unroll") for (int k = 0; k < 2; ++k) dst[n][k] = *(const PG8_LAS bf16x8*)(lds + PG8_SB(b, h) + boff + n * 2048 + k * 1024); } while (0)
#define PG8_MMA(ai, bj, At, Bt) do { __builtin_amdgcn_s_setprio(1); _Pragma("unroll") for (int m = 0; m < 4; ++m) _Pragma("unroll") for (int n = 0; n < 2; ++n) { \
        if constexpr (FP8) { acc[ai][bj][m][n] = __builtin_amdgcn_mfma_scale_f32_16x16x128_f8f6f4(__builtin_shufflevector(__builtin_bit_cast(i32x4, Bt[n][0]), __builtin_bit_cast(i32x4, Bt[n][1]), 0, 1, 2, 3, 4, 5, 6, 7), \
                __builtin_shufflevector(__builtin_bit_cast(i32x4, At[m][0]), __builtin_bit_cast(i32x4, At[m][1]), 0, 1, 2, 3, 4, 5, 6, 7), acc[ai][bj][m][n], 0, 0, 0, Sched::SCALE_B, 0, Sched::SCALE_A); } \
        else { _Pragma("unroll") for (int k = 0; k < 2; ++k) acc[ai][bj][m][n] = __builtin_amdgcn_mfma_f32_16x16x32_bf16(Bt[n][k], At[m][k], acc[ai][bj][m][n], 0, 0, 0); } } \
        __builtin_amdgcn_s_setprio(0); } while (0)
#define PG8_WAIT_V(n) asm volatile("s_waitcnt vmcnt(" #n ")" ::: "memory")
#define PG8_WAIT_L(n) asm volatile("s_waitcnt lgkmcnt(" #n ")" ::: "memory")
#define PG8_BAR __builtin_amdgcn_s_barrier()
#define PG8_SCHED __builtin_amdgcn_sched_barrier(0)
    Unit cur, nxt; int ui = 0;
    if (!S.next(0, cur)) return;
    f32x4 acc[2][2][4][2];
#pragma unroll
    for (int a = 0; a < 2; ++a)
#pragma unroll
        for (int b = 0; b < 2; ++b)
#pragma unroll
            for (int m = 0; m < 4; ++m)
#pragma unroll
                for (int n = 0; n < 2; ++n) acc[a][b][m][n] = (f32x4){0.f, 0.f, 0.f, 0.f};
    bf16x8 At[4][2], B0[2][2], B1[2][2];
    unsigned coff[2][2];
    S.a_offs(cur, R, C, coff);
    const char* cA = S.a_base(cur); const char* cB0 = S.b_base(cur, 0); const char* cB1 = S.b_base(cur, 1);
    PG8_STAGE_B(PG8_SB(0, 0), cB0, 0u); PG8_STAGE_B(PG8_SB(0, 1), cB1, 0u); PG8_STAGE_A(PG8_SA(0, 0), 0, cA, coff, 0u); PG8_STAGE_A(PG8_SA(0, 1), 1, cA, coff, 0u);
    if (wr == 1) PG8_BAR;
    PG8_WAIT_V(2); PG8_BAR;
    PG8_STAGE_B(PG8_SB(1, 0), cB0, kstep); PG8_STAGE_A(PG8_SA(1, 0), 0, cA, coff, kstep); PG8_STAGE_B(PG8_SB(1, 1), cB1, kstep);
    PG8_WAIT_V(6); PG8_BAR;
    for (;;) {
        const bool has_next = S.next(ui + 1, nxt);
        const char* nA = cA; const char* nB0 = cB0; const char* nB1 = cB1;
        if (has_next) { nA = S.a_base(nxt); nB0 = S.b_base(nxt, 0); nB1 = S.b_base(nxt, 1); }
#pragma unroll 1
        for (int t = 0; t < nt; t += 2) {
            const bool last = (t == nt - 2);
            const unsigned a1k = (unsigned)(t + 1) * kstep;
            const char* a2 = last ? nA : cA; const char* b20 = last ? nB0 : cB0; const char* b21 = last ? nB1 : cB1;
            const unsigned a2k = last ? 0u : (unsigned)(t + 2) * kstep, a3k = a2k + kstep;
            PG8_LDB(B0, 0, 0); PG8_LDB(B1, 0, 1); PG8_SCHED; PG8_LDA(At, 0, 0); PG8_STAGE_A(PG8_SA(1, 1), 1, cA, coff, a1k);
            if (Sched::UNIT_OFFS) { if (last && has_next) S.a_offs(nxt, R, C, coff); }
            PG8_WAIT_V(8); PG8_WAIT_L(0); PG8_BAR; PG8_MMA(0, 0, At, B0); PG8_MMA(0, 1, At, B1); PG8_BAR; PG8_SCHED;
            PG8_LDA(At, 0, 1); PG8_STAGE_B(PG8_SB(0, 0), b20, a2k); PG8_STAGE_B(PG8_SB(0, 1), b21, a2k); PG8_STAGE_A(PG8_SA(0, 0), 0, a2, coff, a2k);
            PG8_WAIT_V(8); PG8_WAIT_L(0); PG8_BAR; PG8_MMA(1, 0, At, B0); PG8_MMA(1, 1, At, B1); PG8_BAR; PG8_SCHED;
            PG8_LDB(B0, 1, 0); PG8_LDB(B1, 1, 1); PG8_SCHED; PG8_LDA(At, 1, 0); PG8_STAGE_A(PG8_SA(0, 1), 1, a2, coff, a2k);
            PG8_WAIT_V(8); PG8_WAIT_L(0); PG8_BAR; PG8_MMA(0, 0, At, B0); PG8_MMA(0, 1, At, B1); PG8_BAR; PG8_SCHED;
            PG8_LDA(At, 1, 1); PG8_STAGE_B(PG8_SB(1, 0), b20, a3k); PG8_STAGE_B(PG8_SB(1, 1), b21, a3k); PG8_STAGE_A(PG8_SA(1, 0), 0, a2, coff, a3k);
            PG8_WAIT_V(8); PG8_WAIT_L(0); PG8_BAR; PG8_MMA(1, 0, At, B0); PG8_MMA(1, 1, At, B1); PG8_BAR; PG8_SCHED;
        }
        if constexpr (ALIGN_EPI) { if (wr == 0) PG8_BAR; }
        { int le_; asm volatile("v_mbcnt_lo_u32_b32 %0, -1, 0\n\tv_mbcnt_hi_u32_b32 %0, -1, %0" : "=v"(le_));
          E(acc, cur, wr, wc, le_ & 15, le_ >> 4); }
        if (!has_next) break;
#pragma unroll
        for (int a = 0; a < 2; ++a)
#pragma unroll
            for (int b = 0; b < 2; ++b)
#pragma unroll
                for (int m = 0; m < 4; ++m)
#pragma unroll
                    for (int n = 0; n < 2; ++n) acc[a][b][m][n] = (f32x4){0.f, 0.f, 0.f, 0.f};
        cur = nxt; cA = nA; cB0 = nB0; cB1 = nB1; ++ui;
        if constexpr (ALIGN_EPI) { if (wr == 1) PG8_BAR; }
    }
    PG8_WAIT_V(0);
    if constexpr (!ALIGN_EPI) { if (wr == 0) PG8_BAR; }
    PG8_BAR;
#undef PG8_SA
#undef PG8_SB
#undef PG8_STAGE_A
#undef PG8_GLDS
#undef PG8_STAGE_B
#undef PG8_LDA
#undef PG8_LDB
#undef PG8_MMA
#undef PG8_WAIT_V
#undef PG8_WAIT_L
#undef PG8_BAR
#undef PG8_SCHED
}

typedef f32x4 Acc[2][2][4][2];

struct EpiProj {
    static constexpr bool PERM = true;
    bf16_t* O; int ldc; const float* bias; bool qscale; unsigned* kmax; bf16_t* kimg; bf16_t* vimg; int pn0  ;
    __device__ __forceinline__ void operator()(const Acc& acc, const Unit& u, int wr, int wc, int fr, int fq) const {
        const int row0 = u.pm * BM + wr * 64 + fr, col0 = (u.pn + pn0) * BM + wc * 32 + 8 * fq;
        const float sc = (qscale && (u.pn < 4 || (u.pn >= 12 && u.pn < 16))) ? QSCALE : 1.f;
        const bool dok = kmax != nullptr && u.pn >= 4 && u.pn < 8; float km[2] = {0.f, 0.f}; const int lane = fq * 16 + fr;
        const bool isk = kimg != nullptr && u.pn >= 4 && u.pn < 8, isv = kimg != nullptr && u.pn >= 8 && u.pn < 12;
        const unsigned bb = (unsigned)(u.pm >> 6) * (8u * 256u * 8192u); const int ktb = (u.pm & 63) * 4 + wr;
        const int kin = (wc >> 1) * 4096 + ((wc & 1) * 4 + fq) * 512 + fr * 8, vin = wc * 2048 + fr * 32 + 8 * fq;
        f32x4 bv[2][2];
#pragma unroll
        for (int bj = 0; bj < 2; ++bj)
#pragma unroll
            for (int n = 0; n < 2; ++n) bv[bj][n] = bias ? *(const f32x4*)(bias + col0 + bj * HALF + 4 * n) : (f32x4){0.f, 0.f, 0.f, 0.f};
#pragma unroll
        for (int ai = 0; ai < 2; ++ai)
#pragma unroll
            for (int m = 0; m < 4; ++m) { char* rowp = (char*)O + 2u * ((unsigned)(row0 + ai * HALF + m * 16) * (unsigned)ldc + (unsigned)col0);
#pragma unroll
                for (int bj = 0; bj < 2; ++bj) { f32x4 v0 = (acc[ai][bj][m][0] + bv[bj][0]) * sc, v1 = (acc[ai][bj][m][1] + bv[bj][1]) * sc;
                    u32x4 w; w.x = cvt_pk_bf16(v0[0], v0[1]); w.y = cvt_pk_bf16(v0[2], v0[3]); w.z = cvt_pk_bf16(v1[0], v1[1]); w.w = cvt_pk_bf16(v1[2], v1[3]);
                    if (isk) __builtin_nontemporal_store(w, (u32x4*)((char*)kimg + 2u * (bb + (unsigned)(((u.pn - 4) * 2 + bj) * 256 + ktb + 2 * ai) * 8192u + (unsigned)(kin + m * 128))));
                    else if (isv) __builtin_nontemporal_store(w, (u32x4*)((char*)vimg + 2u * (bb + (unsigned)(((u.pn - 8) * 2 + bj) * 256 + ktb + 2 * ai) * 8192u + (unsigned)(vin + m * 512))));
                    else *(u32x4*)(rowp + 2 * bj * HALF) = w;
                    if (dok) { float ss = bf_lo(w.x) * bf_lo(w.x) + bf_hi(w.x) * bf_hi(w.x) + bf_lo(w.y) * bf_lo(w.y) + bf_hi(w.y) * bf_hi(w.y) + bf_lo(w.z) * bf_lo(w.z) + bf_hi(w.z) * bf_hi(w.z) + bf_lo(w.w) * bf_lo(w.w) + bf_hi(w.w) * bf_hi(w.w);
                        ss += shx(ss, 16, lane); ss += shx(ss, 32, lane); km[bj] = fmaxf(km[bj], ss); } } }
        if (dok) {
#pragma unroll
            for (int bj = 0; bj < 2; ++bj) { float v = km[bj];
#pragma unroll
                for (int o = 1; o < 16; o <<= 1) v = fmaxf(v, shx(v, o, lane));
                v *= 1.0001f;
                if (lane == 0) __hip_atomic_fetch_max(kmax + (u.pm >= (NTOK / 2) / BM ? 32 : 0) + (u.pn - 4) * 8 + bj * 4 + wc, __float_as_uint(v), RLX_AGENT); }
        }
    }
};
template <bool ADD> struct EpiGate {
    static constexpr bool PERM = true;
    bf16_t* O; const bf16_t* G; int gcol;
    __device__ __forceinline__ void operator()(const Acc& acc, const Unit& u, int wr, int wc, int fr, int fq) const {
        const int row0 = u.pm * BM + wr * 64 + fr, col0 = u.pn * BM + wc * 32 + 8 * fq;
#pragma unroll
        for (int ai = 0; ai < 2; ++ai)
#pragma unroll
            for (int mp = 0; mp < 2; ++mp)
#pragma unroll
            for (int bj = 0; bj < 2; ++bj) {
                u32x4 gg[2], tt[2];
#pragma unroll
                for (int mm = 0; mm < 2; ++mm) { const unsigned row = (unsigned)(row0 + ai * HALF + (mp * 2 + mm) * 16);
                    gg[mm] = *(const u32x4*)((const char*)G + 2u * (row * (unsigned)INW + (unsigned)(gcol + col0 + bj * HALF)));
                    tt[mm] = ADD ? *(const u32x4*)((const char*)O + 2u * (row * (unsigned)DM + (unsigned)(col0 + bj * HALF))) : (u32x4){0u, 0u, 0u, 0u}; }
#pragma unroll
                for (int mm = 0; mm < 2; ++mm) { const int m = mp * 2 + mm; const unsigned row = (unsigned)(row0 + ai * HALF + m * 16);
                    const u32x4 g = gg[mm], t = tt[mm]; char* op = (char*)O + 2u * (row * (unsigned)DM + (unsigned)(col0 + bj * HALF));
                    const f32x4 a0 = acc[ai][bj][m][0], a1 = acc[ai][bj][m][1];
                    float r[8];
                    r[0] = sigmoidf_(bf_lo(g.x)) * a0[0]; r[1] = sigmoidf_(bf_hi(g.x)) * a0[1]; r[2] = sigmoidf_(bf_lo(g.y)) * a0[2]; r[3] = sigmoidf_(bf_hi(g.y)) * a0[3];
                    r[4] = sigmoidf_(bf_lo(g.z)) * a1[0]; r[5] = sigmoidf_(bf_hi(g.z)) * a1[1]; r[6] = sigmoidf_(bf_lo(g.w)) * a1[2]; r[7] = sigmoidf_(bf_hi(g.w)) * a1[3];
                    if (ADD) { r[0] += bf_lo(t.x); r[1] += bf_hi(t.x); r[2] += bf_lo(t.y); r[3] += bf_hi(t.y); r[4] += bf_lo(t.z); r[5] += bf_hi(t.z); r[6] += bf_lo(t.w); r[7] += bf_hi(t.w); }
                    u32x4 w; w.x = cvt_pk_bf16(r[0], r[1]); w.y = cvt_pk_bf16(r[2], r[3]); w.z = cvt_pk_bf16(r[4], r[5]); w.w = cvt_pk_bf16(r[6], r[7]);
                    *(u32x4*)op = w; }
            }
    }
};
struct EpiRes {
    static constexpr bool PERM = true;
    const float* Xf; const bf16_t* Xb; bf16_t* O; const float* bias;
    __device__ __forceinline__ void operator()(const Acc& acc, const Unit& u, int wr, int wc, int fr, int fq) const {
        float alpha_; asm volatile("s_mov_b32 %0, 0x3fb504f3" : "=s"(alpha_));
        const int row0 = u.pm * BM + wr * 64 + fr, col0 = u.pn * BM + wc * 32 + 8 * fq;
        f32x4 bv[2][2];
#pragma unroll
        for (int bj = 0; bj < 2; ++bj)
#pragma unroll
            for (int n = 0; n < 2; ++n) bv[bj][n] = *(const f32x4*)(bias + col0 + bj * HALF + 4 * n);
#pragma unroll
        for (int ai = 0; ai < 2; ++ai)
#pragma unroll
            for (int mp = 0; mp < 2; ++mp) {
                f32x4 x0[2][2], x1[2][2];
#pragma unroll
                for (int mm = 0; mm < 2; ++mm)
#pragma unroll
                    for (int bj = 0; bj < 2; ++bj) { const unsigned off = (unsigned)(row0 + ai * HALF + (mp * 2 + mm) * 16) * (unsigned)DM + (unsigned)(col0 + bj * HALF);
                        if (Xb) { const u32x4 xx = *(const u32x4*)((const char*)Xb + 2u * off); x0[mm][bj] = (f32x4){bf_lo(xx.x), bf_hi(xx.x), bf_lo(xx.y), bf_hi(xx.y)}; x1[mm][bj] = (f32x4){bf_lo(xx.z), bf_hi(xx.z), bf_lo(xx.w), bf_hi(xx.w)}; }
                        else { x0[mm][bj] = *(const f32x4*)((const char*)Xf + 4u * off); x1[mm][bj] = *(const f32x4*)((const char*)Xf + 4u * off + 16); } }
#pragma unroll
                for (int mm = 0; mm < 2; ++mm)
#pragma unroll
                    for (int bj = 0; bj < 2; ++bj) { const int m = mp * 2 + mm; const unsigned off = (unsigned)(row0 + ai * HALF + m * 16) * (unsigned)DM + (unsigned)(col0 + bj * HALF);
                        const f32x4 v0 = x0[mm][bj] * alpha_ + acc[ai][bj][m][0] + bv[bj][0], v1 = x1[mm][bj] * alpha_ + acc[ai][bj][m][1] + bv[bj][1];
                        u32x4 w; w.x = cvt_pk_bf16(v0[0], v0[1]); w.y = cvt_pk_bf16(v0[2], v0[3]); w.z = cvt_pk_bf16(v1[0], v1[1]); w.w = cvt_pk_bf16(v1[2], v1[3]);
                        *(u32x4*)((char*)O + 2u * off) = w; }
            }
    }
};
struct EpiPle {
    static constexpr bool PERM = true;
    const bf16_t* X1; bf16_t* O; const bf16_t* TPP;
    __device__ __forceinline__ void operator()(const Acc& acc, const Unit& u, int wr, int wc, int fr, int fq) const {
        float alpha_; asm volatile("s_mov_b32 %0, 0x3fb504f3" : "=s"(alpha_));
        const int row0 = u.pm * BM + wr * 64 + fr, col0 = u.pn * BM + wc * 32 + 8 * fq;
#pragma unroll
        for (int ai = 0; ai < 2; ++ai)
#pragma unroll
            for (int mp = 0; mp < 2; ++mp) {
                u32x4 xs[2][2], ts[2][2];
#pragma unroll
                for (int mm = 0; mm < 2; ++mm)
#pragma unroll
                    for (int bj = 0; bj < 2; ++bj) { const unsigned off = (unsigned)(row0 + ai * HALF + (mp * 2 + mm) * 16) * (unsigned)DM + (unsigned)(col0 + bj * HALF); xs[mm][bj] = *(const u32x4*)((const char*)X1 + 2u * off); ts[mm][bj] = *(const u32x4*)((const char*)TPP + 2u * off); }
#pragma unroll
                for (int mm = 0; mm < 2; ++mm)
#pragma unroll
                    for (int bj = 0; bj < 2; ++bj) { const int m = mp * 2 + mm; const unsigned off = (unsigned)(row0 + ai * HALF + m * 16) * (unsigned)DM + (unsigned)(col0 + bj * HALF);
                        const u32x4 xx = xs[mm][bj], tp = ts[mm][bj]; const f32x4 a0 = acc[ai][bj][m][0], a1 = acc[ai][bj][m][1]; float r[8];
                        r[0] = bf_lo(xx.x) * alpha_ + sigmoidf_(a0[0]) * bf_lo(tp.x); r[1] = bf_hi(xx.x) * alpha_ + sigmoidf_(a0[1]) * bf_hi(tp.x);
                        r[2] = bf_lo(xx.y) * alpha_ + sigmoidf_(a0[2]) * bf_lo(tp.y); r[3] = bf_hi(xx.y) * alpha_ + sigmoidf_(a0[3]) * bf_hi(tp.y);
                        r[4] = bf_lo(xx.z) * alpha_ + sigmoidf_(a1[0]) * bf_lo(tp.z); r[5] = bf_hi(xx.z) * alpha_ + sigmoidf_(a1[1]) * bf_hi(tp.z);
                        r[6] = bf_lo(xx.w) * alpha_ + sigmoidf_(a1[2]) * bf_lo(tp.w); r[7] = bf_hi(xx.w) * alpha_ + sigmoidf_(a1[3]) * bf_hi(tp.w);
                        u32x4 w; w.x = cvt_pk_bf16(r[0], r[1]); w.y = cvt_pk_bf16(r[2], r[3]); w.z = cvt_pk_bf16(r[4], r[5]); w.w = cvt_pk_bf16(r[6], r[7]);
                        *(u32x4*)((char*)O + 2u * off) = w; }
            }
    }
};
}

namespace moe {
using pg8::Unit; using pg8::BM; using pg8::HALF; using pg8::Acc;
struct TabPtr { int base; __device__ __forceinline__ int operator[](int i) const { return *(const LAS int*)(uintptr_t)(unsigned)(base + 4 * i); } };
struct Tables { static constexpr TabPtr cnt{LC_CNT}, offs{LC_OFFS}, mts{LC_MTS}; };
__device__ __forceinline__ int find_expert(const Tables& T, int mt) { int e = 0;
#pragma unroll
    for (int j = 1; j < NEXP; ++j) e += (T.mts[j] <= mt) ? 1 : 0;
    return __builtin_amdgcn_readfirstlane(e); }
constexpr float XSC = 4.0f, WGUSC = 32.0f, ACTSC = 4.0f, WDNSC = 64.0f, YSC = 32.0f;
struct Sched1 {
    static constexpr bool UNIT_OFFS = true; static constexpr int SCALE_A = 0x7D7D7D7D  , SCALE_B = 0x7A7A7A7A  ;
    Tables T; const char* X1B  ; const char* WguT  ; const LAS unsigned* tokc; int G, c, total;
    static __device__ __forceinline__ bool map(int i, int G, int c, int total, int& pm, int& pn) {
        const int x = c & 7, j = c >> 3; pm = (G >> 3) * i + (G >> 5) * (x & 3) + (j >> 2); pn = 4 * (x >> 2) + (j & 3); return pm * 8 < total; }
    __device__ __forceinline__ bool next(int i, Unit& u) const { if (!map(i, G, c, total, u.pm, u.pn)) return false; u.ex = find_expert(T, u.pm) | (i << 8); return true; }
    __device__ __forceinline__ const char* a_base(const Unit&) const { return X1B; }
    __device__ __forceinline__ void a_offs(const Unit& u, const int (&R)[2], const int (&C)[2], unsigned (&off)[2][2]) const {
        const int ui = u.ex >> 8;
#pragma unroll
        for (int h = 0; h < 2; ++h)
#pragma unroll
            for (int i = 0; i < 2; ++i) off[h][i] = tokc[ui * 256 + h * HALF + R[i]] * (unsigned)DM + (unsigned)C[i] * 2u;
    }
    __device__ __forceinline__ const char* b_base(const Unit& u, int h) const { const int e = u.ex & 255; return WguT + ((size_t)e * 2048 + h * 1024 + u.pn * HALF) * DM; }
};
struct Sched2 {
    static constexpr bool UNIT_OFFS = false; static constexpr int SCALE_A = 0x7D7D7D7D  , SCALE_B = 0x79797979  ;
    Tables T; const char* ACT  ; const char* WdnT  ; int G, c, total, pn;
    __device__ __forceinline__ bool next(int i, Unit& u) const { u.pm = G * i + c; u.pn = pn; if (u.pm >= total) return false; u.ex = find_expert(T, u.pm); return true; }
    __device__ __forceinline__ const char* a_base(const Unit& u) const { return ACT + (size_t)u.pm * BM * DM; }
    __device__ __forceinline__ void a_offs(const Unit&, const int (&R)[2], const int (&C)[2], unsigned (&off)[2][2]) const {
#pragma unroll
        for (int h = 0; h < 2; ++h)
#pragma unroll
            for (int i = 0; i < 2; ++i) off[h][i] = (unsigned)((h * HALF + R[i]) * DM) + (unsigned)C[i] * 2u;
    }
    __device__ __forceinline__ const char* b_base(const Unit& u, int h) const { return WdnT + ((size_t)u.ex * 1024 + u.pn * BM + h * HALF) * DM; }
};
struct EpiAct {
    static constexpr bool PERM = true;
    unsigned char* ACT  ; const float* bgu  ;
    __device__ __forceinline__ void operator()(const Acc& acc, const Unit& u, int wr, int wc, int fr, int fq) const {
        constexpr float C1 = -1.702f * LOG2E;
        const int e = u.ex & 255; const int row0 = u.pm * BM + wr * 64 + fr, colh = wc * 32 + 8 * fq, col0 = u.pn * HALF + colh;
        const float* bg = bgu + (size_t)e * 2048 + col0; f32x2 bgc[4], bg4[4], bu1[4];
#pragma unroll
        for (int n = 0; n < 2; ++n) { const f32x4 g4_ = *(const f32x4*)(bg + 4 * n), u4_ = *(const f32x4*)(bg + 1024 + 4 * n);
            bgc[2 * n] = (f32x2){g4_[0], g4_[1]} * C1; bgc[2 * n + 1] = (f32x2){g4_[2], g4_[3]} * C1; bg4[2 * n] = (f32x2){g4_[0], g4_[1]} * ACTSC; bg4[2 * n + 1] = (f32x2){g4_[2], g4_[3]} * ACTSC;
            bu1[2 * n] = (f32x2){u4_[0], u4_[1]} + 1.0f; bu1[2 * n + 1] = (f32x2){u4_[2], u4_[3]} + 1.0f; }
#pragma unroll
        for (int ai = 0; ai < 2; ++ai)
#pragma unroll
            for (int m = 0; m < 4; ++m) { f32x2 r[4];
#pragma unroll
                for (int p = 0; p < 4; ++p) { const int n = p >> 1, j = (p & 1) * 2;
                    const f32x2 ag = (f32x2){acc[ai][0][m][n][j], acc[ai][0][m][n][j + 1]}, au = (f32x2){acc[ai][1][m][n][j], acc[ai][1][m][n][j + 1]};
                    f32x2 arg = ag * C1 + bgc[p]; arg.x = fmaxf(arg.x, 7.0f * C1); arg.y = fmaxf(arg.y, 7.0f * C1);
                    f32x2 g4 = ag * ACTSC + bg4[p]; g4.x = fminf(g4.x, 7.0f * ACTSC); g4.y = fminf(g4.y, 7.0f * ACTSC);
                    f32x2 u1 = au + bu1[p]; u1.x = __builtin_amdgcn_fmed3f(u1.x, -6.0f, 8.0f); u1.y = __builtin_amdgcn_fmed3f(u1.y, -6.0f, 8.0f);
                    f32x2 ex; ex.x = __builtin_amdgcn_exp2f(arg.x); ex.y = __builtin_amdgcn_exp2f(arg.y);
                    const f32x2 dn = ex + 1.0f; f32x2 rc; rc.x = __builtin_amdgcn_rcpf(dn.x); rc.y = __builtin_amdgcn_rcpf(dn.y);
                    r[p] = (g4 * rc) * u1; }
                u32x2 w; w.x = pk4_fp8(r[0].x, r[0].y, r[1].x, r[1].y); w.y = pk4_fp8(r[2].x, r[2].y, r[3].x, r[3].y);
                *(u32x2*)(ACT + ((unsigned)(row0 + ai * HALF + m * 16) * (unsigned)DM + (unsigned)col0)) = w; }
    }
};
struct EpiY {
    static constexpr bool PERM = true;
    unsigned char* Y  ; const float* bdn  ; const float* lgate  ; Tables T;
    __device__ __forceinline__ void operator()(const Acc& acc, const Unit& u, int wr, int wc, int fr, int fq) const {
        const int e = u.ex; const int row0 = u.pm * BM + wr * 64 + fr, col0 = u.pn * BM + wc * 32 + 8 * fq;
        const int base = T.offs[e], cnt = T.cnt[e];
#pragma unroll
        for (int bj = 0; bj < 2; ++bj) {
            const f32x4 b0 = *(const f32x4*)(bdn + (size_t)e * DM + col0 + bj * HALF), b1 = *(const f32x4*)(bdn + (size_t)e * DM + col0 + bj * HALF + 4);
#pragma unroll
            for (int ai = 0; ai < 2; ++ai)
#pragma unroll
                for (int m = 0; m < 4; ++m) { const int row = row0 + ai * HALF + m * 16; const int pos = row - base; const float g = (pos < cnt) ? lgate[(unsigned)(e * LIST_CAP + pos)] * YSC : 0.f;
                    const f32x4 v0 = (acc[ai][bj][m][0] + b0) * g, v1 = (acc[ai][bj][m][1] + b1) * g;
                    u32x2 w; w.x = pk4_fp8(v0[0], v0[1], v0[2], v0[3]); w.y = pk4_fp8(v1[0], v1[1], v1[2], v1[3]);
                    *(u32x2*)(Y + ((unsigned)row * (unsigned)DM + (unsigned)(col0 + bj * HALF))) = w; }
        }
    }
};
}

namespace att {
#ifndef PINGPONG
#define PINGPONG 0
#endif
#ifndef ATT_SB
#define ATT_SB 0
#endif
constexpr int PITCH = INW;
constexpr int KSLOT = 16384, VSLOT = 16384, NSLOT = 4, LDS_K = 0, LDS_V = NSLOT * KSLOT;
constexpr int OST = 132;
__device__ __forceinline__ int crow(int r, int hi) { return (r & 3) + 8 * (r >> 2) + 4 * hi; }
__device__ __forceinline__ void glds16(const void* gsrc, unsigned lds_dst) { unsigned keep;
    asm volatile("s_mov_b32 %0, m0\n\ts_mov_b32 m0, %2\n\ts_nop 0\n\tglobal_load_lds_dwordx4 %1, off\n\ts_mov_b32 m0, %0" : "=&s"(keep) : "v"(gsrc), "s"(lds_dst) : "memory"); }
__device__ __forceinline__ void glds16s(const void* sbase, unsigned voff, unsigned lds_dst) { unsigned keep;
    asm volatile("s_mov_b32 %0, m0\n\ts_mov_b32 m0, %3\n\ts_nop 0\n\tglobal_load_lds_dwordx4 %1, %2\n\ts_mov_b32 m0, %0" : "=&s"(keep) : "v"(voff), "s"(sbase), "s"(lds_dst) : "memory"); }
__device__ __forceinline__ void glds16s2(const void* sbase, unsigned voff, unsigned lds_dst) { unsigned keep;
    asm volatile("s_mov_b32 %0, m0\n\ts_mov_b32 m0, %3\n\ts_nop 0\n\tglobal_load_lds_dwordx4 %1, %2\n\tglobal_load_lds_dwordx4 %1, %2 offset:1024\n\ts_mov_b32 m0, %0" : "=&s"(keep) : "v"(voff), "s"(sbase), "s"(lds_dst) : "memory"); }
__device__ __forceinline__ float max3f(float a, float b, float c) { float r; asm("v_max3_f32 %0, %1, %2, %3" : "=v"(r) : "v"(a), "v"(b), "v"(c)); return r; }
typedef short v4i16_t __attribute__((ext_vector_type(4)));
__device__ __forceinline__ s16x4 vtr(const LAS unsigned char* p) { return __builtin_bit_cast(s16x4, __builtin_amdgcn_ds_read_tr16_b64_v4i16((LAS v4i16_t*)p)); }
#define ATT_WAIT_BAR(N) asm volatile("s_waitcnt vmcnt(" #N ") lgkmcnt(0)\n\ts_barrier" ::: "memory")

struct Args { const bf16_t* proj; unsigned char* out  ; const float* subw; const float* sinks; float lam, oscale; const unsigned* kmax; const bf16_t* kimg; const bf16_t* vimg; };
struct OrderTab { unsigned short v[2048]; unsigned short seg[9]; };
constexpr int est_cost(int u) { const int qt = u >> 4, h = u & 7; const int reach[8] = {5, 9, 15, 27, 52, 102, 202, 258};     const int c = 2 * qt + 2; return (c < reach[h] ? c : reach[h]) + 3; }
constexpr OrderTab make_order() { OrderTab t{};
    int gcost[64] = {}; for (int g = 0; g < 64; ++g) { const int bh = g >> 2, r = g & 3; for (int k = 0; k < 32; ++k) gcost[g] += est_cost((127 - 32 * r - k) * 16 + bh); }
    int ord[64] = {}; bool used[64] = {};
    for (int i = 0; i < 64; ++i) { int best = -1; for (int g = 0; g < 64; ++g) if (!used[g] && (best < 0 || gcost[g] > gcost[best])) best = g; used[best] = true; ord[i] = best; }
    int load[8] = {}; int own[64] = {};
    for (int i = 0; i < 64; ++i) { int x = 0; for (int j = 1; j < 8; ++j) if (load[j] < load[x]) x = j; own[ord[i]] = x; load[x] += gcost[ord[i]]; }
    int p = 0;
    for (int x = 0; x < 8; ++x) { t.seg[x] = (unsigned short)p;
        for (int i = 0; i < 64; ++i) { const int g = ord[i]; if (own[g] != x) continue; const int bh = g >> 2, r = g & 3;
            for (int k = 0; k < 32; ++k) t.v[p++] = (unsigned short)((127 - 32 * r - k) * 16 + bh); } }
    t.seg[8] = (unsigned short)p; return t; }
__device__ const OrderTab g_order = make_order();

template <bool SWA, bool FAST>
__device__ __forceinline__ void tile_loop(f32x16 (&o)[SWA ? 2 : 4], const bf16x8 (&qr)[4], float& mhat, float& lsum, int& NT, LAS unsigned char* lds, const LAS unsigned char* kp0, const LAS unsigned char* vp0,
                                          LAS float* wsf, const bf16_t* ksrc  , const bf16_t* vsrc, const unsigned koff  , const unsigned voff, const unsigned kdst, const unsigned vdst, const float cb, const float bnd,
                                          const int qt, const int q0, const int qrel, const int hi, const int r32, const int lane, const int wid, const int half) {
    constexpr int ND = SWA ? 2 : 4;
#define ATT_DMA(kt_, slot_) do { const size_t toff_ = (size_t)(kt_) * (SWA ? 64 * PITCH : 8192); const unsigned so_ = (unsigned)(slot_); \
        if (SWA) { glds16s(ksrc + toff_, koff, (unsigned)__builtin_amdgcn_readfirstlane(kdst + so_ * KSLOT)); \
                   glds16s(vsrc + toff_, voff, (unsigned)__builtin_amdgcn_readfirstlane(vdst + so_ * VSLOT)); } \
        else { glds16s2(ksrc + toff_, koff, (unsigned)__builtin_amdgcn_readfirstlane(kdst + so_ * KSLOT)); \
               glds16s2(vsrc + toff_, voff, (unsigned)__builtin_amdgcn_readfirstlane(vdst + so_ * VSLOT)); } } while (0)
#define ATT_KT(i_) ((i_) == 0 ? 2 * qt : ((i_) == 1 ? 2 * qt + 1 : 2 * qt + 1 - (i_)))
    ATT_DMA(ATT_KT(0), 0); ATT_DMA(ATT_KT(1), 1); if (NT > 2) ATT_DMA(ATT_KT(2), 2);
    if (SWA && NT > 3) ATT_DMA(ATT_KT(3), 3);
    int g = 0;
#define ATT_BARRIER() do { \
        if ((g & 1) == 0) { const int t_ = g >> 1; if (SWA) { if (t_ == 0) ATT_WAIT_BAR(0); }   \
            else if (t_ + 2 < NT) ATT_WAIT_BAR(8); else if (t_ + 1 < NT) ATT_WAIT_BAR(4); else ATT_WAIT_BAR(0); } \
        else { if (PINGPONG) asm volatile("s_waitcnt lgkmcnt(0)\n\ts_barrier" ::: "memory"); } \
        if (!SWA && g == 2) { \
            const LAS float* dq = (const LAS float*)(lds + LC_WSF) + 8 * 64; float dmax = dq[0]; \
            _Pragma("unroll") for (int w = 1; w < 8; ++w) dmax = fmaxf(dmax, dq[w]); \
            const float lim = ((float)(q0 - 63) - (dmax + 2.0f)) * (1.0f / 64.0f); \
            int kt_lo = (int)ceilf(lim); kt_lo = kt_lo < 0 ? 0 : kt_lo; kt_lo = __builtin_amdgcn_readfirstlane(kt_lo); \
            const int ntn = 2 * qt + 2 - kt_lo; NT = ntn < 2 ? 2 : (ntn < NT ? ntn : NT); } \
        if (!SWA && (g & 1)) { const int t2_ = (g >> 1) + 3; if (t2_ < NT) { const int s2_ = t2_ & 3; ATT_DMA(ATT_KT(t2_), s2_); } } \
        ++g; } while (0)
    if (PINGPONG && half == 1) ATT_BARRIER();
    float cstep[8];
#pragma unroll
    for (int m = 1; m < 8; ++m) cstep[m] = __builtin_bit_cast(float, __builtin_amdgcn_readfirstlane(__builtin_bit_cast(int, cb * (float)(8 * m))));
#define ATT_CINIT() do { float bs_[4]; bs_[0] = nb; bs_[1] = nb + cb; bs_[2] = fmaf(cb, 2.0f, nb); bs_[3] = fmaf(cb, 3.0f, nb); \
        _Pragma("unroll") for (int r = 0; r < 16; ++r) { const int m_ = r >> 2; float a_, b_; \
            if (m_ == 0) a_ = bs_[r & 3]; else asm("v_add_f32 %0, %1, %2" : "=v"(a_) : "s"(cstep[m_]), "v"(bs_[r & 3])); \
            asm("v_add_f32 %0, %1, %2" : "=v"(b_) : "s"(cstep[m_ + 4]), "v"(bs_[r & 3])); c0[r] = a_; c1[r] = b_; } } while (0)
    int slot = 0;
#pragma unroll 1
    for (int i = 0; i < NT; ++i) {
        ATT_BARRIER();
        if (SWA) { const bool lowq = (wid & 3) < 2; if (lowq ? (i == 1) : (i == 3)) { ATT_BARRIER(); slot = (slot + 1) & 3; continue; } }
        const int kt = ATT_KT(i); const int rel = 64 * (kt - 2 * qt);
        const LAS unsigned char* kp = kp0 + slot * KSLOT;
        const float nb = -mhat - cb * (float)(qrel - rel - 4 * hi);
        f32x16 c0, c1;
        if (FAST) {
            bf16x8 kf[8];
#pragma unroll
            for (int d0 = 0; d0 < 4; ++d0) { kf[2 * d0] = *(const LAS bf16x8*)(kp + d0 * 2048); kf[2 * d0 + 1] = *(const LAS bf16x8*)(kp + d0 * 2048 + 512); }
            ATT_CINIT();
            __builtin_amdgcn_sched_barrier(0);
#pragma unroll
            for (int d0 = 0; d0 < 4; ++d0) {
                c0 = __builtin_amdgcn_mfma_f32_32x32x16_bf16(kf[2 * d0], qr[d0], c0, 0, 0, 0);
                c1 = __builtin_amdgcn_mfma_f32_32x32x16_bf16(kf[2 * d0 + 1], qr[d0], c1, 0, 0, 0);
            }
            __builtin_amdgcn_sched_barrier(0);
        } else {
            ATT_CINIT();
#pragma unroll
            for (int d0 = 0; d0 < 4; ++d0) {
                const bf16x8 k0 = *(const LAS bf16x8*)(kp + d0 * 2048), k1 = *(const LAS bf16x8*)(kp + d0 * 2048 + 512);
                c0 = __builtin_amdgcn_mfma_f32_32x32x16_bf16(k0, qr[d0], c0, 0, 0, 0);
                c1 = __builtin_amdgcn_mfma_f32_32x32x16_bf16(k1, qr[d0], c1, 0, 0, 0);
            }
        }
        if (SWA ? (((wid & 3) < 2) ? (i != 2) : (i != 0)) : (i < 2)) {
            const int dd = qrel - rel - 4 * hi;
#pragma unroll
            for (int r = 0; r < 16; ++r) { const int d0_ = dd - ((r & 3) + 8 * (r >> 2)), d1_ = d0_ - 32;
                const bool v0 = SWA ? ((unsigned)d0_ < 128u) : (d0_ >= 0), v1 = SWA ? ((unsigned)d1_ < 128u) : (d1_ >= 0);
                c0[r] = v0 ? c0[r] : -INFINITY; c1[r] = v1 ? c1[r] : -INFINITY; }
        }
        float fsc = 1.0f;
        if (!FAST || i == 0) {
        float rm = max3f(c0[0], c1[0], c0[1]), rm2 = max3f(c1[1], c0[2], c1[2]);
#pragma unroll
        for (int r = 3; r < 15; r += 2) { rm = max3f(rm, c0[r], c1[r]); rm2 = max3f(rm2, c0[r + 1], c1[r + 1]); }
        rm = max3f(rm, c0[15], c1[15]); rm = max3f(rm, rm2, rm2);
        { auto rr = __builtin_amdgcn_permlane32_swap(__float_as_uint(rm), __float_as_uint(rm), false, false); rm = max3f(__uint_as_float(rr[0]), __uint_as_float(rr[1]), __uint_as_float(rr[1])); }
        if (i == 0) {
            mhat = rm;
#pragma unroll
            for (int r = 0; r < 16; ++r) { c0[r] -= rm; c1[r] -= rm; }
            if (!SWA) { float tq = (bnd - mhat + 128.0f) / cb;
#pragma unroll
                for (int o_ = 1; o_ < 32; o_ <<= 1) tq = fmaxf(tq, shx(tq, o_, lane));
                if (lane == 0) ((LAS float*)(lds + LC_WSF))[8 * 64 + wid] = tq; }
        } else if (!FAST) {
            const float dl = rm > 8.0f ? rm : 0.f; mhat += dl;
#pragma unroll
            for (int r = 0; r < 16; ++r) { c0[r] -= dl; c1[r] -= dl; }
            fsc = __builtin_amdgcn_exp2f(-dl); lsum *= fsc;
        }
        }
        if (!FAST) {
            if (hi == 0) wsf[r32] = fsc;
            asm volatile("s_waitcnt lgkmcnt(0)" ::: "memory");
#pragma unroll
            for (int r = 0; r < 16; ++r) { const float fr_ = wsf[crow(r, hi)];
#pragma unroll
                for (int d = 0; d < ND; ++d) { float t_ = o[d][r]; asm("v_mul_f32 %0, %1, %0" : "+v"(t_) : "v"(fr_)); o[d][r] = t_; } }
            asm volatile("s_waitcnt lgkmcnt(0)" ::: "memory");
        }
        float sacc = 0.f;
#pragma unroll
        for (int r = 0; r < 16; ++r) { c0[r] = __builtin_amdgcn_exp2f(c0[r]); c1[r] = __builtin_amdgcn_exp2f(c1[r]); sacc += c0[r] + c1[r]; }
        lsum += sacc;
        u32x4 pw[4];
#pragma unroll
        for (int j = 0; j < 4; ++j) { pw[0][j] = cvt_pk_bf16(c0[2 * j], c0[2 * j + 1]); pw[1][j] = cvt_pk_bf16(c0[8 + 2 * j], c0[9 + 2 * j]);
                                      pw[2][j] = cvt_pk_bf16(c1[2 * j], c1[2 * j + 1]); pw[3][j] = cvt_pk_bf16(c1[8 + 2 * j], c1[9 + 2 * j]); }
        ATT_BARRIER();
        const LAS unsigned char* vp = vp0 + slot * VSLOT;
        s16x4 vlo[2][4], vhi[2][4];
#define ATT_VLOAD(buf, d) do { _Pragma("unroll") for (int ks = 0; ks < 4; ++ks) { vlo[buf][ks] = vtr(vp + (d) * 4096 + ks * 1024); vhi[buf][ks] = vtr(vp + (d) * 4096 + ks * 1024 + 512); } } while (0)
#define ATT_VMMA(buf, d) do { _Pragma("unroll") for (int ks = 0; ks < 4; ++ks) { \
            const s16x4 lo_ = vlo[buf][ks], hh_ = vhi[buf][ks]; const bf16x8 vf_ = (bf16x8){lo_[0], lo_[1], lo_[2], lo_[3], hh_[0], hh_[1], hh_[2], hh_[3]}; \
            o[d] = __builtin_amdgcn_mfma_f32_32x32x16_bf16(__builtin_bit_cast(bf16x8, pw[ks]), vf_, o[d], 0, 0, 0); } } while (0)
        if (FAST) {
            ATT_VLOAD(0, 0); ATT_VLOAD(1, 1);
            __builtin_amdgcn_sched_barrier(0);
            ATT_VMMA(0, 0);
            __builtin_amdgcn_sched_barrier(0);
            ATT_VLOAD(0, 2); __builtin_amdgcn_sched_barrier(0);
            ATT_VMMA(1, 1);
            __builtin_amdgcn_sched_barrier(0);
            ATT_VLOAD(1, 3); __builtin_amdgcn_sched_barrier(0); ATT_VMMA(0, 2); __builtin_amdgcn_sched_barrier(0); ATT_VMMA(1, 3); __builtin_amdgcn_sched_barrier(0);
        } else {
#pragma unroll
            for (int d = 0; d < ND; ++d) { ATT_VLOAD(0, d); __builtin_amdgcn_sched_barrier(0); ATT_VMMA(0, d); __builtin_amdgcn_sched_barrier(0); }
        }
#undef ATT_VLOAD
#undef ATT_VMMA
        slot = (slot + 1) & 3;
    }
    if (PINGPONG && half == 0) ATT_BARRIER();
#undef ATT_BARRIER
#undef ATT_DMA
#undef ATT_KT
}
template <bool SWA>
__device__ __forceinline__ void attn_unit(const Args& A, int uid, LAS unsigned char* lds, const int wave_) {
    int l_; asm volatile("v_mbcnt_lo_u32_b32 %0, -1, 0\n\tv_mbcnt_hi_u32_b32 %0, -1, %0" : "=v"(l_));
    const int tid = wave_ * 64 + l_;
    constexpr int ND = SWA ? 2 : 4;
    constexpr int NDMA = SWA ? 2 : 4;
    const int lane = tid & 63, r32 = lane & 31, hi = lane >> 5;
    const int wid = __builtin_amdgcn_readfirstlane(tid >> 6), half = wid >> 2, quarter = wid & 3;
    int b, qt, hsel, kvh = 0, ocol0; float slope;
    if (!SWA) { const int bh = uid & 15; qt = uid >> 4; b = bh >> 3; hsel = bh & 7; slope = __builtin_amdgcn_exp2f(-(float)(hsel + 1)); ocol0 = hsel * 128; }
    else { b = uid & 1; kvh = (uid >> 1) & 1; const int j = (uid >> 2) & 3; qt = uid >> 4; hsel = kvh * 8 + 2 * j; slope = __builtin_amdgcn_exp2f(-0.5f * (float)(hsel + half + 1)); ocol0 = hsel * 64; }
    const float cb = slope * LOG2E;
    const size_t rowbase = (size_t)b * SEQ; const int q0 = qt * 128;
    const bf16_t* Qw = A.proj + (rowbase + q0 + quarter * 32) * PITCH + (SWA ? (COL_SQ + (hsel + half) * 64) : (COL_DQ + hsel * 128 + half * 64));
    const bf16_t* Kg = A.proj + rowbase * PITCH + (SWA ? (COL_SK + kvh * 64) : (COL_DK + hsel * 128));
    const bf16_t* Vg = A.proj + rowbase * PITCH + (SWA ? (COL_SV + kvh * 64) : (COL_DV + hsel * 128));
    const unsigned lds0 = (unsigned)(uintptr_t)lds;
    const bf16_t* ksrc = SWA ? Kg : A.kimg + (size_t)(b * 8 + hsel) * 256 * 8192;
    const bf16_t* vsrc = SWA ? Vg : A.vimg + (size_t)(b * 8 + hsel) * 256 * 8192;
    const unsigned koff = 2u * (unsigned)(SWA ? lane * PITCH + wid * 8 : wid * 1024 + lane * 8);
    const unsigned voff = 2u * (unsigned)(SWA ? (16 * (wid & 3) + (lane >> 2)) * PITCH + (wid >> 2) * 32 + (lane & 3) * 8 : wid * 1024 + lane * 8);
    const unsigned kdst = lds0 + LDS_K + wid * (SWA ? 1024 : 2048), vdst = lds0 + LDS_V + wid * (SWA ? 1024 : 2048);
    const LAS unsigned char* kp0 = lds + LDS_K + (SWA ? 0 : half * 8192) + hi * 1024 + r32 * 16;
    const LAS unsigned char* vp0 = lds + LDS_V + ((lane >> 4) & 1) * 32 + (lane & 3) * 8 + (4 * hi + ((lane & 15) >> 2)) * 64;
    LAS float* wsf = (LAS float*)(lds + LC_WSF) + wid * 64;
    bf16x8 qr[4];
#pragma unroll
    for (int d0 = 0; d0 < 4; ++d0) qr[d0] = *(const bf16x8*)(Qw + (size_t)r32 * PITCH + d0 * 16 + hi * 8);
    int NT = SWA ? (qt == 0 ? 2 : 4) : (2 * qt + 2);
    float bnd = 0.f;
    if (!SWA) { float qn = 0.f;
#pragma unroll
        for (int d0 = 0; d0 < 4; ++d0)
#pragma unroll
            for (int e = 0; e < 8; ++e) { const float qv = __uint_as_float(((unsigned)(unsigned short)qr[d0][e]) << 16); qn += qv * qv; }
        { auto rr = __builtin_amdgcn_permlane32_swap(__float_as_uint(qn), __float_as_uint(qn), false, false); qn = __uint_as_float(rr[0]) + __uint_as_float(rr[1]); }
        const unsigned* kmp = A.kmax + b * 32 + hsel * 4 + half * 2;
        const float k2 = __uint_as_float(__hip_atomic_load(kmp, RLX_AGENT)) + __uint_as_float(__hip_atomic_load(kmp + 1, RLX_AGENT));
        bnd = sqrtf(qn * k2) * 1.001f + 0.01f; }
    f32x16 o[ND];
#pragma unroll
    for (int d = 0; d < ND; ++d) o[d] = f32x16{};
    float mhat = 0.f, lsum = 0.f;
    const int qrel = quarter * 32 + r32;
    if (!SWA && !__any(bnd > 48.0f)) tile_loop<SWA, true>(o, qr, mhat, lsum, NT, lds, kp0, vp0, wsf, ksrc, vsrc, koff, voff, kdst, vdst, cb, bnd, qt, q0, qrel, hi, r32, lane, wid, half);
    else tile_loop<SWA, false>(o, qr, mhat, lsum, NT, lds, kp0, vp0, wsf, ksrc, vsrc, koff, voff, kdst, vdst, cb, bnd, qt, q0, qrel, hi, r32, lane, wid, half);
    int le_; asm volatile("v_mbcnt_lo_u32_b32 %0, -1, 0\n\tv_mbcnt_hi_u32_b32 %0, -1, %0" : "=v"(le_));
    const int tid_e = wave_ * 64 + le_, r32_e = le_ & 31, hi_e = le_ >> 5;
    LAS float* wsf_e = (LAS float*)(lds + LC_WSF) + wid * 64;
    { auto rr = __builtin_amdgcn_permlane32_swap(__float_as_uint(lsum), __float_as_uint(lsum), false, false); lsum = __uint_as_float(rr[0]) + __uint_as_float(rr[1]); }
    if (SWA) lsum += __builtin_amdgcn_exp2f(A.sinks[hsel + half] * LOG2E - mhat);
    if (hi_e == 0) wsf_e[32 + r32_e] = lsum;
    asm volatile("s_waitcnt lgkmcnt(0)" ::: "memory");
    float rli[16];
#pragma unroll
    for (int r = 0; r < 16; ++r) rli[r] = __builtin_amdgcn_rcpf(wsf_e[32 + crow(r, hi_e)]);
    ATT_WAIT_BAR(0);
    LAS float* ost = (LAS float*)(lds + LDS_K);
    if (!SWA) {
        if (half == 1) {
#pragma unroll
            for (int r = 0; r < 16; ++r)
#pragma unroll
                for (int d = 0; d < ND; ++d) ost[(quarter * 32 + crow(r, hi_e)) * OST + d * 32 + r32_e] = A.lam * o[d][r] * rli[r];
        }
        ATT_WAIT_BAR(0);
        if (half == 0) {
#pragma unroll
            for (int r = 0; r < 16; ++r)
#pragma unroll
                for (int d = 0; d < ND; ++d) { LAS float* p = ost + (quarter * 32 + crow(r, hi_e)) * OST + d * 32 + r32_e; *p = o[d][r] * rli[r] - *p; }
        }
        ATT_WAIT_BAR(0);
    } else {
#pragma unroll
        for (int r = 0; r < 16; ++r)
#pragma unroll
            for (int d = 0; d < ND; ++d) ost[(quarter * 32 + crow(r, hi_e)) * OST + half * 64 + d * 32 + r32_e] = o[d][r] * rli[r];
        ATT_WAIT_BAR(0);
    }
    {
        const int row = tid_e >> 2, cq = tid_e & 3; const LAS float* p = ost + row * OST + cq * 32; f32x4 v[8]; float ss = 0.f;
#pragma unroll
        for (int j = 0; j < 8; ++j) { v[j] = *(const LAS f32x4*)(p + 4 * j); ss += v[j][0] * v[j][0] + v[j][1] * v[j][1] + v[j][2] * v[j][2] + v[j][3] * v[j][3]; }
        float rs = 1.f;
        if (!SWA) { ss += dpp_xor1(ss); ss += dpp_xor2(ss); rs = A.oscale / sqrtf(ss * (1.0f / 128.0f) + RMS_EPS); }
        unsigned char* op = A.out + (rowbase + q0 + row) * DM + ocol0 + cq * 32;
        rs *= ATT_OSC;
#pragma unroll
        for (int j = 0; j < 8; j += 2) { f32x4 a = v[j] * rs, c = v[j + 1] * rs;
            if (!SWA) { const f32x4 w0 = *(const f32x4*)(A.subw + cq * 32 + 4 * j), w1 = *(const f32x4*)(A.subw + cq * 32 + 4 * j + 4); a = a * w0; c = c * w1; }
            u32x2 w; w.x = pk4_fp8(a[0], a[1], a[2], a[3]); w.y = pk4_fp8(c[0], c[1], c[2], c[3]);
            *(u32x2*)(op + 4 * j) = w; }
    }
    ATT_WAIT_BAR(0);
}
template <bool SWA, class BgF>
__device__ __forceinline__ void attn_phase(const Args& A, unsigned* qhead, int nunits, LAS unsigned char* lds, const int wave, const BgF& bgf, const int bid) {
    volatile LAS unsigned* bc = (volatile LAS unsigned*)(lds + LC_MISC) + 16;
    const int myx = SWA ? 0 : (int)((unsigned)__builtin_amdgcn_s_getreg((3 << 11) | 20) & 7u);
    int cnt = bid;
#pragma unroll 1
    for (int pass = 0; pass < (SWA ? 1 : 8); ++pass) {
        const int x = (myx + pass) & 7; const int s0 = SWA ? 0 : (int)g_order.seg[x], s1 = SWA ? nunits : (int)g_order.seg[x + 1];
        if (!SWA && pass >= 1) {
            if (pass == 1) { int l_; asm volatile("v_mbcnt_lo_u32_b32 %0, -1, 0\n\tv_mbcnt_hi_u32_b32 %0, -1, %0" : "=v"(l_));
                if (wave == 0 && l_ < 8) bc[4 + l_] = __hip_atomic_load(qhead + 64 * l_, RLX_AGENT);
                __syncthreads(); }
            if ((int)bc[4 + x] >= s1 - s0) continue;
        }
        for (;;) {
            const bool wantbg = (cnt % BgF::EVERY) == 0; ++cnt;
            { int l_; asm volatile("v_mbcnt_lo_u32_b32 %0, -1, 0\n\tv_mbcnt_hi_u32_b32 %0, -1, %0" : "=v"(l_));
              if (wave == 0 && l_ == 0) { const unsigned a_ = __hip_atomic_fetch_add(qhead + (SWA ? 0 : 64 * x), 1u, RLX_AGENT); unsigned b_ = (unsigned)BgF::TOTAL;
                  if (wantbg) b_ = __hip_atomic_fetch_add(bgf.ctr, 1u, RLX_AGENT); bc[0] = a_; bc[1] = b_; } }
            __syncthreads();
            const int u = s0 + (int)bc[0]; const int bi = (int)bc[1];
            __syncthreads();
            if (u >= s1) { if (bi < BgF::TOTAL) bgf(bi, lds, wave); break; }
            if (bi < BgF::TOTAL) bgf(bi, lds, wave);
            attn_unit<SWA>(A, SWA ? u : (int)g_order.v[u], lds, wave);
        }
    }
}
template <class BgF>
__device__ __forceinline__ void bg_drain(LAS unsigned char* lds, const int wave, const BgF& bgf) {
    volatile LAS unsigned* bc = (volatile LAS unsigned*)(lds + LC_MISC) + 16;
    for (;;) {
        { int l_; asm volatile("v_mbcnt_lo_u32_b32 %0, -1, 0\n\tv_mbcnt_hi_u32_b32 %0, -1, %0" : "=v"(l_));
          if (wave == 0 && l_ == 0) bc[1] = __hip_atomic_fetch_add(bgf.ctr, 1u, RLX_AGENT); }
        __syncthreads();
        const int bi = (int)bc[1];
        __syncthreads();
        if (bi >= BgF::TOTAL) break;
        bgf(bi, lds, wave);
    }
    __syncthreads();
}
}

#define XB_TMO      128
#define XB_XCNT(j)  (256  + 64 * (j))
#define XB_XSUB(j)  (1280 + 64 * (j))
#define XB_XGEN(j)  (2304 + 64 * (j))
#define XB_TOP      3328
#define XB_TOPGEN   3392
#define XCD_BAR_WORDS 3456
#define XB_SPIN_CAP (1u << 18)
__device__ __forceinline__ unsigned xb_ld(unsigned* p)              { return __hip_atomic_load(p, __ATOMIC_RELAXED, __HIP_MEMORY_SCOPE_AGENT); }
__device__ __forceinline__ unsigned xb_add(unsigned* p, unsigned v) { return __hip_atomic_fetch_add(p, v, __ATOMIC_RELAXED, __HIP_MEMORY_SCOPE_AGENT); }
__device__ __forceinline__ unsigned xb_xcc_id() { return (unsigned)__builtin_amdgcn_s_getreg((3 << 11) | 20) & 0xFu; }
#define XB_SPIN(cond, bar) do { unsigned _sp = 0; while (cond) { __builtin_amdgcn_s_sleep(1); \
    if ((++_sp & 255u) == 0u) { if (xb_ld(&(bar)[XB_TMO])) break; if (_sp > XB_SPIN_CAP) { atomicAdd(&(bar)[XB_TMO], 1u); break; } } } } while (0)
struct XcdBarrier { unsigned* bar; unsigned x; volatile LAS unsigned* st; };
__device__ __forceinline__ XcdBarrier xcd_barrier_post(unsigned* bar, volatile LAS unsigned* st) {
    XcdBarrier b; b.bar = bar; b.x = xb_xcc_id(); b.st = st;
    if (threadIdx.x == 0) (void)xb_add(&bar[XB_XCNT(b.x)], 1u);
    return b;
}
__device__ __forceinline__ void xcd_barrier_complete(unsigned* bar, unsigned x, unsigned& nloc, unsigned& nx) {
    const unsigned G = gridDim.x * gridDim.y * gridDim.z;
    unsigned sum, cnt, mine, sp = 0u;
    for (;;) {
        sum = 0u; cnt = 0u; mine = 0u;
#pragma unroll
        for (unsigned j = 0; j < 16; ++j) { const unsigned c = xb_ld(&bar[XB_XCNT(j)]); sum += c; cnt += (c > 0u) ? 1u : 0u; mine = (j == x) ? c : mine; }
        if (sum == G) break;
        __builtin_amdgcn_s_sleep(1);
        if ((++sp & 255u) == 0u) { if (xb_ld(&bar[XB_TMO])) break; if (sp > XB_SPIN_CAP) { atomicAdd(&bar[XB_TMO], 1u); break; } }
    }
    nloc = mine > 0u ? mine : 1u; nx = cnt > 0u ? cnt : 1u;
}
__device__ __forceinline__ void xcd_barrier(const XcdBarrier& b) {
    asm volatile("s_waitcnt vmcnt(0)" ::: "memory");
    __syncthreads();
    if (threadIdx.x == 0) {
        unsigned* bar = b.bar;
        __builtin_amdgcn_s_waitcnt(0);
        unsigned nloc = b.st[0], nx = b.st[1];
        if (nloc == 0u) { xcd_barrier_complete(bar, b.x, nloc, nx); b.st[0] = nloc; b.st[1] = nx; }
        const unsigned old = xb_add(&bar[XB_XSUB(b.x)], 1u);
        const unsigned gen = old / nloc;
        if (old + 1u == (gen + 1u) * nloc) {
            __builtin_amdgcn_fence(__ATOMIC_RELEASE, "agent");
            asm volatile("s_waitcnt vmcnt(0)" ::: "memory");
            const unsigned og = xb_add(&bar[XB_TOP], 1u);
            const unsigned tg = og / nx;
            if (og + 1u == (tg + 1u) * nx) xb_add(&bar[XB_TOPGEN], 1u);
            else XB_SPIN(xb_ld(&bar[XB_TOPGEN]) == tg, bar);
            __builtin_amdgcn_fence(__ATOMIC_ACQUIRE, "agent");
            xb_add(&bar[XB_XGEN(b.x)], 1u);
            asm volatile("s_waitcnt vmcnt(0)" ::: "memory");
        } else {
            XB_SPIN(xb_ld(&bar[XB_XGEN(b.x)]) == gen, bar);
            __builtin_amdgcn_fence(__ATOMIC_ACQUIRE, "agent");
            asm volatile("s_waitcnt vmcnt(0)" ::: "memory");
        }
    }
    __syncthreads();
}

constexpr int NWAVES = 8;
struct Frame { LAS unsigned char* lds; unsigned* ctl; int tid, lane, wave, G, bid; };

__device__ __forceinline__ unsigned f2bf(float f) { unsigned u = __builtin_bit_cast(unsigned, f); return (u + 0x7fffu + ((u >> 16) & 1u)) >> 16; }
__device__ __forceinline__ unsigned pk2(float lo, float hi) { return f2bf(lo) | (f2bf(hi) << 16); }

__device__ __forceinline__ void p0_transpose_item(const float* W, int K, int N, bf16_t* WT, LAS float* scr, int item, int lane) {
    const int nblk = N / 32, kb = item / nblk, nb = item % nblk, k0 = 64 * kb, n0 = 32 * nb;
    float wv_[32];
#pragma unroll
    for (int i = 0; i < 32; ++i) wv_[i] = W[(size_t)(k0 + 2 * i + (lane >> 5)) * N + n0 + (lane & 31)];
#pragma unroll
    for (int i = 0; i < 32; ++i) scr[(2 * i + (lane >> 5)) * 33 + (lane & 31)] = wv_[i];
    LDS_WAIT(); asm volatile("" ::: "memory");
    const int c = lane & 7;
#pragma unroll
    for (int j = 0; j < 4; ++j) { const int n = (lane >> 3) + 8 * j; const LAS float* s = scr + (8 * c) * 33 + n;
        u32x4 o; o.x = pk2(s[0 * 33], s[1 * 33]); o.y = pk2(s[2 * 33], s[3 * 33]); o.z = pk2(s[4 * 33], s[5 * 33]); o.w = pk2(s[6 * 33], s[7 * 33]);
        *(u32x4*)(WT + (size_t)(n0 + n) * K + k0 + 8 * c) = o; }
    LDS_WAIT(); asm volatile("" ::: "memory");
}
__device__ __forceinline__ void bg_tile_load(float (&v)[64], const float* W, int N, int k0, int n0, int lane) {
    const float* src = W + (size_t)(k0 + 64 * (lane >> 5)) * N + n0 + (lane & 31);
#pragma unroll
    for (int i = 0; i < 64; ++i) v[i] = src[(size_t)i * N];
}
__device__ __forceinline__ void bg_tile_store(const float (&v)[64], unsigned char* WT, int K, int k0, int n0, int lane, float sc) {
    unsigned char* dst = WT + (size_t)(n0 + (lane & 31)) * K + k0 + 64 * (lane >> 5);
#pragma unroll
    for (int q = 0; q < 4; ++q) { u32x4 o;
        o.x = pk4_fp8(v[16 * q + 0] * sc, v[16 * q + 1] * sc, v[16 * q + 2] * sc, v[16 * q + 3] * sc);     o.y = pk4_fp8(v[16 * q + 4] * sc, v[16 * q + 5] * sc, v[16 * q + 6] * sc, v[16 * q + 7] * sc);
        o.z = pk4_fp8(v[16 * q + 8] * sc, v[16 * q + 9] * sc, v[16 * q + 10] * sc, v[16 * q + 11] * sc);   o.w = pk4_fp8(v[16 * q + 12] * sc, v[16 * q + 13] * sc, v[16 * q + 14] * sc, v[16 * q + 15] * sc);
        *(u32x4*)(dst + 16 * q) = o; }
}
__device__ __forceinline__ void p0_transpose_stack(const Frame& F, const float* W, bf16_t* WT, int nmat, int K, int N, LAS float* scr) {
    const int per = (K / 64) * (N / 32), total = nmat * per; const int gw = F.bid * NWAVES + F.wave, NGW = F.G * NWAVES;
    for (int it = gw; it < total; it += NGW) { const int mi = it / per, r = it % per; p0_transpose_item(W + (size_t)mi * K * N, K, N, WT + (size_t)mi * K * N, scr, r, F.lane); }
}
__device__ __forceinline__ void cvt_rows_bf16(const Frame& F, const float* __restrict__ src, bf16_t* __restrict__ dst, size_t n  , unsigned char* __restrict__ dst8 = nullptr  ) {
    const size_t gt = (size_t)F.bid * (NWAVES * 64) + F.tid, NT = (size_t)F.G * NWAVES * 64;
    for (size_t i0 = gt * 8; i0 < n; i0 += NT * 8 * 4) { f32x4 a[4], b[4];
#pragma unroll
        for (int q = 0; q < 4; ++q) { const size_t i = i0 + (size_t)q * NT * 8; if (i < n) { a[q] = *(const f32x4*)(src + i); b[q] = *(const f32x4*)(src + i + 4); } }
#pragma unroll
        for (int q = 0; q < 4; ++q) { const size_t i = i0 + (size_t)q * NT * 8; if (i < n) {
            u32x4 w; w.x = cvt_pk_bf16(a[q][0], a[q][1]); w.y = cvt_pk_bf16(a[q][2], a[q][3]); w.z = cvt_pk_bf16(b[q][0], b[q][1]); w.w = cvt_pk_bf16(b[q][2], b[q][3]); *(u32x4*)(dst + i) = w;
            if (dst8) { u32x2 w8; w8.x = pk4_fp8(a[q][0] * XIN_SC, a[q][1] * XIN_SC, a[q][2] * XIN_SC, a[q][3] * XIN_SC); w8.y = pk4_fp8(b[q][0] * XIN_SC, b[q][1] * XIN_SC, b[q][2] * XIN_SC, b[q][3] * XIN_SC); *(u32x2*)(dst8 + i) = w8; } } } }
}

__device__ __forceinline__ void moe_tables(const Frame& F, const unsigned* gcnt  ) {
    LAS int* cnt = (LAS int*)(F.lds + LC_CNT); LAS int* offs = (LAS int*)(F.lds + LC_OFFS); LAS int* mts = (LAS int*)(F.lds + LC_MTS);
    __syncthreads();
    if (F.tid < NEXP) cnt[F.tid] = (int)__hip_atomic_load(gcnt + 64 * F.tid, RLX_AGENT);
    __syncthreads();
    if (F.tid == 0) { int o = 0; for (int e = 0; e < NEXP; ++e) { offs[e] = o; mts[e] = o >> 8; o += (cnt[e] + 255) & ~255; } offs[NEXP] = o; mts[NEXP] = o >> 8; }
    __syncthreads();
}

__device__ __forceinline__ void ln_row_stats(f32x4 (&v)[4], const f32x4 (&gg)[4], const f32x4 (&bb)[4], int lane, float& mean_o, float& rstd_o) {
    float s = 0.f;
#pragma unroll
    for (int j = 0; j < 4; ++j) s += (v[j][0] + v[j][1]) + (v[j][2] + v[j][3]);
    const float mean = wave_sum(s, lane) * (1.f / DM); float s2 = 0.f;
#pragma unroll
    for (int j = 0; j < 4; ++j) { v[j] = v[j] - mean; s2 += (v[j][0] * v[j][0] + v[j][1] * v[j][1]) + (v[j][2] * v[j][2] + v[j][3] * v[j][3]); }
    const float rstd = 1.f / sqrtf(wave_sum(s2, lane) * (1.f / DM) + LN_EPS);
#pragma unroll
    for (int j = 0; j < 4; ++j) v[j] = v[j] * rstd * gg[j] + bb[j];
    mean_o = mean; rstd_o = rstd;
}
__device__ __forceinline__ void ln_row_pre(f32x4 (&v)[4], const f32x4 (&gg)[4], const f32x4 (&bb)[4], int lane) {
    float s = 0.f;
#pragma unroll
    for (int j = 0; j < 4; ++j) s += (v[j][0] + v[j][1]) + (v[j][2] + v[j][3]);
    const float mean = wave_sum(s, lane) * (1.f / DM); float s2 = 0.f;
#pragma unroll
    for (int j = 0; j < 4; ++j) { v[j] = v[j] - mean; s2 += (v[j][0] * v[j][0] + v[j][1] * v[j][1]) + (v[j][2] * v[j][2] + v[j][3] * v[j][3]); }
    const float rstd = 1.f / sqrtf(wave_sum(s2, lane) * (1.f / DM) + LN_EPS);
#pragma unroll
    for (int j = 0; j < 4; ++j) v[j] = v[j] * rstd * gg[j] + bb[j];
}
__device__ __forceinline__ void ln_row(f32x4 (&v)[4], const float* g, const float* bta, int lane) {
    float s = 0.f;
#pragma unroll
    for (int j = 0; j < 4; ++j) s += (v[j][0] + v[j][1]) + (v[j][2] + v[j][3]);
    const float mean = wave_sum(s, lane) * (1.f / DM); float s2 = 0.f;
#pragma unroll
    for (int j = 0; j < 4; ++j) { v[j] = v[j] - mean; s2 += (v[j][0] * v[j][0] + v[j][1] * v[j][1]) + (v[j][2] * v[j][2] + v[j][3] * v[j][3]); }
    const float rstd = 1.f / sqrtf(wave_sum(s2, lane) * (1.f / DM) + LN_EPS);
#pragma unroll
    for (int j = 0; j < 4; ++j) { const f32x4 gg = *(const f32x4*)(g + 4 * lane + 256 * j), bb = *(const f32x4*)(bta + 4 * lane + 256 * j); v[j] = v[j] * rstd * gg + bb; }
}

__device__ __forceinline__ void phase_ln_router(const Frame& F, const bf16_t* pre, const float* g, const float* bta, bf16_t* x1b, unsigned char* x1f8,
                                                const float* wr  , const float* br, unsigned* gcnt, unsigned* ltok, float* lgate, int* toke, int* tokp) {
    LAS unsigned char* WH = F.lds + RING_OFF; LAS unsigned char* WL = WH + 65536;
    LAS int* lcnt = (LAS int*)(F.lds + LC_LCNT); LAS int* gbase = lcnt + 32;
    LAS float* lg = (LAS float*)(F.lds + LC_TOKC) + F.wave * (16 * 36);
    LAS int* ent_e = (LAS int*)(F.lds + LC_ENT); LAS int* ent_p = ent_e + 512; LAS float* ent_g = (LAS float*)(ent_p + 512);
    LAS float* part = (LAS float*)(F.lds + LC_ENT);
    LAS float* sE = (LAS float*)(F.lds + LC_LOG); LAS float* cE = sE + 32;
    LAS float* stats = (LAS float*)(F.lds + LC_WSF) + F.wave * 32;
    __syncthreads();
    float sp = 0.f, cp = 0.f;
#pragma unroll 1
    for (int it = 0; it < (DM * NEXP) / (NWAVES * 64 * 16); ++it) { float wv[16], gv[16], bv[16];
#pragma unroll
        for (int j = 0; j < 16; ++j) { const int idx = F.tid + (it * 16 + j) * (NWAVES * 64); wv[j] = wr[idx]; gv[j] = g[idx >> 5]; bv[j] = bta[idx >> 5]; }
#pragma unroll
        for (int j = 0; j < 16; ++j) { const int idx = F.tid + (it * 16 + j) * (NWAVES * 64); const int d = idx >> 5, e = idx & 31; const float w = wv[j] * gv[j];
            const unsigned hb = cvt_pk_bf16(w, 0.f) & 0xffffu; const float wl = w - __uint_as_float(hb << 16); const unsigned lb = cvt_pk_bf16(wl, 0.f) & 0xffffu;
            sp += __uint_as_float(hb << 16) + __uint_as_float(lb << 16); cp += bv[j] * wv[j];
            const int off = e * 2048 + ((((d >> 3) ^ (e & 7))) << 4) + (d & 7) * 2;
            *(LAS unsigned short*)(WH + off) = (unsigned short)hb; *(LAS unsigned short*)(WL + off) = (unsigned short)lb; } }
    part[(F.tid >> 5) * 32 + (F.tid & 31)] = sp; part[512 + (F.tid >> 5) * 32 + (F.tid & 31)] = cp;
    __syncthreads();
    if (F.tid < 32) { float a = 0.f, c = 0.f;
#pragma unroll
        for (int i = 0; i < 16; ++i) { a += part[i * 32 + F.tid]; c += part[512 + i * 32 + F.tid]; }
        sE[F.tid] = a; cE[F.tid] = c + br[F.tid]; }
    __syncthreads();
    const int lane = F.lane;
    const int mrow = lane & 15, kq = lane >> 4;
    for (int chunk = F.bid; chunk < NTOK / 128; chunk += F.G) {
        __syncthreads();
        if (F.tid < 32) lcnt[F.tid] = 0;
        __syncthreads();
        const size_t row0 = (size_t)chunk * 128 + F.wave * 16;
        f32x4 gg[4], bb[4];
#pragma unroll
        for (int j = 0; j < 4; ++j) { gg[j] = *(const f32x4*)(g + 4 * lane + 256 * j); bb[j] = *(const f32x4*)(bta + 4 * lane + 256 * j); }
#pragma unroll 1
        for (int rb = 0; rb < 16; rb += 8) {
            u32x2 raw[8][4];
#pragma unroll
            for (int r = 0; r < 8; ++r)
#pragma unroll
                for (int j = 0; j < 4; ++j) raw[r][j] = *(const u32x2*)(pre + (row0 + rb + r) * DM + 4 * lane + 256 * j);
#pragma unroll
            for (int r = 0; r < 8; ++r) { const size_t row = row0 + rb + r;
                f32x4 v[4];
#pragma unroll
                for (int j = 0; j < 4; ++j) v[j] = (f32x4){bf_lo(raw[r][j].x), bf_hi(raw[r][j].x), bf_lo(raw[r][j].y), bf_hi(raw[r][j].y)};
                float mean_, rstd_;
                ln_row_stats(v, gg, bb, lane, mean_, rstd_);
                if (lane == 0) { stats[2 * (rb + r)] = mean_; stats[2 * (rb + r) + 1] = rstd_; }
#pragma unroll
                for (int j = 0; j < 4; ++j) {
                    u32x2 w; w.x = cvt_pk_bf16(v[j][0], v[j][1]); w.y = cvt_pk_bf16(v[j][2], v[j][3]); *(u32x2*)(x1b + row * DM + 4 * lane + 256 * j) = w;
                    *(unsigned*)(x1f8 + row * DM + 4 * lane + 256 * j) = pk4_fp8(v[j][0] * 4.0f, v[j][1] * 4.0f, v[j][2] * 4.0f, v[j][3] * 4.0f); }
            }
        }
        f32x4 lacc[2] = {(f32x4){0.f, 0.f, 0.f, 0.f}, (f32x4){0.f, 0.f, 0.f, 0.f}};
        const bf16_t* xp = pre + (row0 + mrow) * DM + kq * 8;
#pragma unroll 8
        for (int ks = 0; ks < 32; ++ks) {
            const bf16x8 ah = *(const bf16x8*)(xp + ks * 32);
#pragma unroll
            for (int nb = 0; nb < 2; ++nb) { const int e = nb * 16 + mrow; const int off = e * 2048 + (((ks * 4 + kq) ^ (e & 7)) << 4);
                const bf16x8 bh = *(const LAS bf16x8*)(WH + off), bl = *(const LAS bf16x8*)(WL + off);
                lacc[nb] = __builtin_amdgcn_mfma_f32_16x16x32_bf16(ah, bh, lacc[nb], 0, 0, 0);
                lacc[nb] = __builtin_amdgcn_mfma_f32_16x16x32_bf16(ah, bl, lacc[nb], 0, 0, 0); }
        }
        LDS_WAIT(); asm volatile("" ::: "memory");
#pragma unroll
        for (int nb = 0; nb < 2; ++nb) { const float se_ = sE[nb * 16 + mrow], ce_ = cE[nb * 16 + mrow];
#pragma unroll
            for (int r = 0; r < 4; ++r) { const float mean_ = stats[2 * (4 * kq + r)], rstd_ = stats[2 * (4 * kq + r) + 1];
                lg[(4 * kq + r) * 36 + nb * 16 + mrow] = rstd_ * (lacc[nb][r] - mean_ * se_) + ce_; } }
        LDS_WAIT(); asm volatile("" ::: "memory");
        if (lane < 16) {
            const int rl = F.wave * 16 + lane;
            float lv[32];
#pragma unroll
            for (int c = 0; c < 8; ++c) { const f32x4 t = *(const LAS f32x4*)(lg + lane * 36 + 4 * c); lv[4 * c] = t[0]; lv[4 * c + 1] = t[1]; lv[4 * c + 2] = t[2]; lv[4 * c + 3] = t[3]; }
            float tv[4]; int ti[4];
#pragma unroll
            for (int k = 0; k < 4; ++k) { float best = -INFINITY; int bi = 0;
#pragma unroll
                for (int e = 0; e < 32; ++e) { const bool gt = lv[e] > best; best = gt ? lv[e] : best; bi = gt ? e : bi; }
                tv[k] = best; ti[k] = bi;
#pragma unroll
                for (int e = 0; e < 32; ++e) lv[e] = (e == bi) ? -INFINITY : lv[e]; }
            const float e1 = __expf(tv[1] - tv[0]), e2 = __expf(tv[2] - tv[0]), e3 = __expf(tv[3] - tv[0]); const float inv = 1.0f / (1.0f + e1 + e2 + e3);
            const float gk[4] = {inv, e1 * inv, e2 * inv, e3 * inv};
#pragma unroll
            for (int k = 0; k < 4; ++k) { const int lp = atomicAdd((int*)(lcnt + ti[k]), 1); ent_e[rl * 4 + k] = ti[k]; ent_p[rl * 4 + k] = lp; ent_g[rl * 4 + k] = gk[k]; }
        }
        __syncthreads();
        if (F.tid < 32) gbase[F.tid] = (int)__hip_atomic_fetch_add(gcnt + 64 * F.tid, (unsigned)lcnt[F.tid], RLX_AGENT);
        __syncthreads();
        { const int idx = F.tid; const int e = ent_e[idx], pos = gbase[e] + ent_p[idx]; const int tk = chunk * 512 + idx;
            ltok[(size_t)e * LIST_CAP + pos] = (unsigned)tk; lgate[(size_t)e * LIST_CAP + pos] = ent_g[idx]; toke[tk] = e; tokp[tk] = pos; }
    }
    __syncthreads();
}

__device__ __forceinline__ void phase_combine_ln(const Frame& F, const bf16_t* __restrict__ pre, const unsigned char* __restrict__ Y, const int* __restrict__ toke, const int* __restrict__ tokp,
                                                 const float* __restrict__ g, const float* __restrict__ bta, float* __restrict__ xo, bf16_t* __restrict__ xob, unsigned char* __restrict__ xob8) {
    const LAS int* offs = (const LAS int*)(F.lds + LC_OFFS);
    const int gw = F.bid * NWAVES + F.wave, NGW = F.G * NWAVES, lane = F.lane;
    f32x4 gg[4], bb[4];
#pragma unroll
    for (int j = 0; j < 4; ++j) { gg[j] = *(const f32x4*)(g + 16 * lane + 4 * j); bb[j] = *(const f32x4*)(bta + 16 * lane + 4 * j); }
    i32x4 te[2], tp[2];
#pragma unroll
    for (int q = 0; q < 2; ++q) { const int r = (gw + q * NGW < NTOK) ? gw + q * NGW : (gw < NTOK ? gw : 0); te[q] = *(const i32x4*)(toke + (size_t)r * 4); tp[q] = *(const i32x4*)(tokp + (size_t)r * 4); }
    for (int row0 = gw; row0 < NTOK; row0 += 2 * NGW) {
        const int rows[2] = {row0, row0 + NGW}; const bool ok1 = rows[1] < NTOK;
        u32x4 pv[2][2], yv[2][4];
#pragma unroll
        for (int q = 0; q < 2; ++q) { const int r = (q == 0 || ok1) ? rows[q] : rows[0];
            pv[q][0] = *(const u32x4*)(pre + (size_t)r * DM + 16 * lane); pv[q][1] = *(const u32x4*)(pre + (size_t)r * DM + 16 * lane + 8);
#pragma unroll
            for (int k = 0; k < 4; ++k) { const size_t slot = (size_t)(offs[te[q][k]] + tp[q][k]); yv[q][k] = *(const u32x4*)(Y + slot * DM + 16 * lane); } }
#pragma unroll
        for (int q = 0; q < 2; ++q) { const int rn = row0 + 2 * NGW + q * NGW; const int r = rn < NTOK ? rn : row0; te[q] = *(const i32x4*)(toke + (size_t)r * 4); tp[q] = *(const i32x4*)(tokp + (size_t)r * 4); }
#pragma unroll
        for (int q = 0; q < 2; ++q) { if (q == 1 && !ok1) break; const int row = rows[q];
            f32x4 v[4];
#pragma unroll
            for (int j = 0; j < 4; ++j) { const unsigned p0 = pv[q][j >> 1][(j & 1) * 2], p1 = pv[q][j >> 1][(j & 1) * 2 + 1];
                f32x4 ys = (f32x4){0.f, 0.f, 0.f, 0.f};
#pragma unroll
                for (int k = 0; k < 4; ++k) { const int yw = (int)yv[q][k][j]; const auto lo = __builtin_amdgcn_cvt_pk_f32_fp8(yw, false), hi = __builtin_amdgcn_cvt_pk_f32_fp8(yw, true);
                    ys[0] += lo[0]; ys[1] += lo[1]; ys[2] += hi[0]; ys[3] += hi[1]; }
                v[j] = (f32x4){bf_lo(p0), bf_hi(p0), bf_lo(p1), bf_hi(p1)} + ys * (1.0f / moe::YSC); }
            ln_row_pre(v, gg, bb, lane);
#pragma unroll
            for (int j = 0; j < 4; ++j) if (xo) *(f32x4*)(xo + (size_t)row * DM + 16 * lane + 4 * j) = v[j];
            if (!xo) {
#pragma unroll
                for (int h = 0; h < 2; ++h) { u32x4 w; w.x = cvt_pk_bf16(v[2 * h][0], v[2 * h][1]); w.y = cvt_pk_bf16(v[2 * h][2], v[2 * h][3]); w.z = cvt_pk_bf16(v[2 * h + 1][0], v[2 * h + 1][1]); w.w = cvt_pk_bf16(v[2 * h + 1][2], v[2 * h + 1][3]);
                    *(u32x4*)(xob + (size_t)row * DM + 16 * lane + 8 * h) = w; }
                u32x4 w8;
#pragma unroll
                for (int j = 0; j < 4; ++j) w8[j] = pk4_fp8(v[j][0] * XIN_SC, v[j][1] * XIN_SC, v[j][2] * XIN_SC, v[j][3] * XIN_SC);
                *(u32x4*)(xob8 + (size_t)row * DM + 16 * lane) = w8; } }
    }
}

struct KArgs { const float* in[26]; float* out; unsigned char* ws; int ph_lo, ph_hi; };
typedef const __attribute__((address_space(4))) KArgs* KAP;
#define KA() ({ KAP p_ = (KAP)__builtin_amdgcn_kernarg_segment_ptr(); asm volatile("" : "+s"(p_)); p_; })
#define KIN(k) ((const float*)ka->in[k])
#define WSP(T, off) ((T*)(ka->ws + (off)))

struct BgStage {
    static constexpr int BG_T = 4, EVERY = 4;
    static constexpr int T_GU = NEXP * (DM / 128) * (2 * DM / 32), T_DN = NEXP * (DM / 128) * (DM / 32), T_PG = (DM / 128) * (DM / 32), T_AB = 2 * T_PG, TOTAL = (T_GU + T_DN + T_PG + T_AB) / (8 * BG_T);
    static_assert(T_GU % (8 * BG_T) == 0 && T_DN % (8 * BG_T) == 0 && T_PG % (8 * BG_T) == 0 && T_AB % (8 * BG_T) == 0 && BG_T % 2 == 0, "block-items do not straddle the two weight stacks");
    unsigned* ctr; int layer;
    struct Tile { const float* W; unsigned char* WT; int N, k0, n0; float sc; };
    __device__ __forceinline__ Tile tile(KAP ka, int t) const { Tile r;
        if (t < T_GU) { const int mi = layer * NEXP + (t >> 9), q = t & 511; r.W = KIN(18) + (size_t)mi * DM * 2 * DM; r.WT = WSP(unsigned char, WS_WGU) + (size_t)mi * DM * 2 * DM; r.N = 2 * DM; r.k0 = (q >> 6) * 128; r.n0 = (q & 63) * 32; r.sc = moe::WGUSC; }
        else if (t >= T_GU + T_DN + T_PG) { const int t3 = t - T_GU - T_DN - T_PG, w_ = t3 >> 8, q = t3 & 255;
            r.W = KIN(10 + w_) + (size_t)layer * DM * DM; r.WT = WSP(unsigned char, w_ ? WS_WB : WS_WA) + (size_t)layer * DM * DM; r.N = DM; r.k0 = (q >> 5) * 128; r.n0 = (q & 31) * 32; r.sc = WAB_SC; }
        else if (t >= T_GU + T_DN) { const int q = t - T_GU - T_DN; r.W = KIN(22) + (size_t)layer * DM * DM; r.WT = WSP(unsigned char, WS_WPG8) + (size_t)layer * DM * DM; r.N = DM; r.k0 = (q >> 5) * 128; r.n0 = (q & 31) * 32; r.sc = WPGSC; }
        else { const int t2 = t - T_GU, mi = layer * NEXP + (t2 >> 8), q = t2 & 255; r.W = KIN(20) + (size_t)mi * DM * DM; r.WT = WSP(unsigned char, WS_WDN) + (size_t)mi * DM * DM; r.N = DM; r.k0 = (q >> 5) * 128; r.n0 = (q & 31) * 32; r.sc = moe::WDNSC; }
        return r; }
    __device__ __forceinline__ void operator()(int bi, LAS unsigned char*, int wave) const {
        int l_; asm volatile("v_mbcnt_lo_u32_b32 %0, -1, 0\n\tv_mbcnt_hi_u32_b32 %0, -1, %0" : "=v"(l_));
        KAP ka = KA();
        const int t0 = bi * (8 * BG_T) + wave;
        float va[64], vb[64];
        Tile ta = tile(ka, t0), tb;
        bg_tile_load(va, ta.W, ta.N, ta.k0, ta.n0, l_);
#pragma unroll
        for (int s_ = 1; s_ < BG_T; s_ += 2) {
            tb = tile(ka, t0 + 8 * s_);
            bg_tile_load(vb, tb.W, tb.N, tb.k0, tb.n0, l_);
            bg_tile_store(va, ta.WT, DM, ta.k0, ta.n0, l_, ta.sc);
            if (s_ + 1 < BG_T) { ta = tile(ka, t0 + 8 * (s_ + 1)); bg_tile_load(va, ta.W, ta.N, ta.k0, ta.n0, l_); }
            bg_tile_store(vb, tb.WT, DM, tb.k0, tb.n0, l_, tb.sc);
        }
    }
};

constexpr int NPH_LAYER = 9, NPHASES = 1 + DEPTH * NPH_LAYER;
__global__ void __launch_bounds__(NWAVES * 64, 2) mk_fwd(KArgs args) {
    extern __shared__ __attribute__((aligned(16))) unsigned char lds_raw[];
    Frame F; F.lds = (LAS unsigned char*)lds_raw; F.tid = threadIdx.x; F.lane = F.tid & 63; F.wave = __builtin_amdgcn_readfirstlane(F.tid >> 6); F.G = gridDim.x; F.bid = blockIdx.x;
    const int wave0 = F.wave;
#define REFRAME() do { int l_; asm volatile("v_mbcnt_lo_u32_b32 %0, -1, 0\n\tv_mbcnt_hi_u32_b32 %0, -1, %0" : "=v"(l_)); int w_ = wave0; asm volatile("" : "+s"(w_)); \
        F.lane = l_; F.wave = w_; F.tid = w_ * 64 + l_; int b_ = blockIdx.x; asm volatile("" : "+s"(b_)); F.bid = b_; } while (0)
    F.ctl = (unsigned*)(args.ws + WS_CTL);
    volatile LAS unsigned* MISC = (volatile LAS unsigned*)(F.lds + LC_MISC);
    if (F.tid < 64) MISC[F.tid] = 0u;
    __syncthreads();
    XcdBarrier bar; bar.bar = F.ctl + CW_BAR; bar.x = 0; bar.st = nullptr;
    if (MK_N_LAUNCHES == 1) bar = xcd_barrier_post(F.ctl + CW_BAR, MISC + 8);
    const int lo = args.ph_lo, hi = args.ph_hi;
#ifndef PH_MASK
#define PH_MASK 0x3ff
#endif
#define PON(id) (((PH_MASK) >> (id)) & 1)
#define IN(k) (lo <= (k) && (k) < hi)
#define SEAM(k) do { if (IN(k) && IN((k) + 1)) xcd_barrier(bar); } while (0)
#ifdef DOUBLE_PHASE
#define NREP(k) (((k) == DOUBLE_PHASE) ? 2 : 1)
#else
#define NREP(k) 1
#endif
#define PHASE_LOOP(k) for (int rep = 0; rep < NREP(k); ++rep)
#define PHASE_REDO(k) do { if (rep + 1 < NREP(k)) xcd_barrier(bar); } while (0)
    if (PON(0) && IN(0)) PHASE_LOOP(0) { REFRAME();
        LAS float* scr = (LAS float*)(F.lds + RING_OFF + F.wave * 16384);
        { KAP ka = KA(); p0_transpose_stack(F, KIN(2), WSP(bf16_t, WS_WIN), DEPTH, DM, INW, scr); }
        { KAP ka = KA(); p0_transpose_stack(F, KIN(12), WSP(bf16_t, WS_WOUT), DEPTH, DM, DM, scr); }
        { KAP ka = KA(); p0_transpose_stack(F, KIN(23), WSP(bf16_t, WS_WPP), DEPTH, PLED, DM, scr); }
        { KAP ka = KA(); cvt_rows_bf16(F, KIN(0), WSP(bf16_t, WS_XB), (size_t)NTOK * DM, WSP(unsigned char, WS_XB8)); }
        { KAP ka = KA();
          for (int t = F.bid * NWAVES + F.wave; t < DEPTH * 512; t += F.G * NWAVES) { const int ly = t >> 9, q = t & 511, k0 = (q >> 6) * 128, n0 = (q & 63) * 32;
              float vt[64]; bg_tile_load(vt, KIN(2) + (size_t)ly * DM * INW + NT_PROJ * 256, INW, k0, n0, F.lane);
              bg_tile_store(vt, WSP(unsigned char, WS_WIN8) + (size_t)ly * 2048 * DM, DM, k0, n0, F.lane, WING_SC); } }
        { KAP ka = KA(); cvt_rows_bf16(F, KIN(1), WSP(bf16_t, WS_PB), (size_t)DEPTH * NTOK * PLED); }
        VM_WAIT(); __syncthreads(); PHASE_REDO(0);
    }
    SEAM(0);

#pragma unroll 1
    for (int layer = 0; layer < DEPTH; ++layer) {
        const int pb = 1 + layer * NPH_LAYER;
        unsigned* gcnt = F.ctl + CW_CNT + layer * NEXP * 64;
        if (PON(1) && IN(pb + 0)) PHASE_LOOP(pb + 0) { REFRAME();
            { KAP ka = KA(); pg8::DenseSched S; S.init(WSP(bf16_t, WS_XB), WSP(bf16_t, WS_WIN) + (size_t)layer * INW * DM, NTOK, NT_PROJ * 256, DM, F.G, F.bid);
              pg8::EpiProj E{WSP(bf16_t, WS_PROJ), INW, KIN(3) + (size_t)layer * INW, true, F.ctl + CW_KMAX + layer * 64, WSP(bf16_t, WS_KIMG), WSP(bf16_t, WS_VIMG), 0};
              pg8::gemm_phase<pg8::EpiProj, pg8::DenseSched>(F.lds + RING_OFF, DM, S, E, F.tid); }
            REFRAME();
            { KAP ka = KA(); pg8::DenseSchedF8in S; S.init(WSP(unsigned char, WS_XB8), WSP(unsigned char, WS_WIN8) + (size_t)layer * 2048 * DM, NTOK, NT_GATE * 256, DM / 2, F.G, F.bid);
              { constexpr int NU = (NTOK / 256) * NT_PROJ, NF = (NTOK / 256) * NT_GATE; const int rem = NU % F.G, num = NF - 2 * (F.G - rem);
                if (rem != 0 && num >= 0 && num % F.G == 0 && (rem % 8) == 0) { S.nl = rem; S.cntL = num / F.G; S.cntS = S.cntL + 2; } }
              pg8::EpiProj E{WSP(bf16_t, WS_PROJ), INW, KIN(3) + (size_t)layer * INW, false, nullptr, nullptr, nullptr, NT_PROJ};
              pg8::gemm_phase<pg8::EpiProj, pg8::DenseSchedF8in, true, true>(F.lds + RING_OFF, DM / 2, S, E, F.tid); }
            REFRAME();
            { KAP ka = KA(); pg8::DenseSched S; S.init(WSP(bf16_t, WS_PB) + (size_t)layer * NTOK * PLED, WSP(bf16_t, WS_WPP) + (size_t)layer * DM * PLED, NTOK, DM, PLED, F.G, F.bid);
              pg8::EpiProj E{WSP(bf16_t, WS_TPP), DM, nullptr, false, nullptr, nullptr, nullptr, 0};
              pg8::gemm_phase<pg8::EpiProj, pg8::DenseSched>(F.lds + RING_OFF, PLED, S, E, F.tid); }
        PHASE_REDO(pb + 0); }
        SEAM(pb + 0);
        if (PON(2) && IN(pb + 1)) PHASE_LOOP(pb + 1) { REFRAME();
            const float lam_init = layer == 0 ? 0.2f : 0.35550906759096926f;
            { KAP ka = KA();
              float d1 = KIN(4)[layer * 64 + F.lane] * KIN(5)[layer * 64 + F.lane], d2 = KIN(6)[layer * 64 + F.lane] * KIN(7)[layer * 64 + F.lane];
              d1 = wave_sum(d1, F.lane); d2 = wave_sum(d2, F.lane);
              float lam, osc;
              { const float lv_ = __expf(d1) - __expf(d2) + lam_init, ov_ = 1.0f - lam_init; unsigned ls_, os_;
                asm volatile("s_nop 7\n\tv_readfirstlane_b32 %0, %2\n\tv_readfirstlane_b32 %1, %3\n\ts_nop 7" : "=&s"(ls_), "=&s"(os_) : "v"(lv_), "v"(ov_)); lam = __uint_as_float(ls_); osc = __uint_as_float(os_); }
              att::Args A{WSP(bf16_t, WS_PROJ), WSP(unsigned char, WS_OD), KIN(8) + layer * 128, KIN(9) + layer * 16, lam, osc, F.ctl + CW_KMAX + layer * 64, WSP(bf16_t, WS_KIMG), WSP(bf16_t, WS_VIMG)};
              att::attn_phase<false>(A, F.ctl + CW_QX + (layer * 2 + rep) * 512, NBATCH * 8 * (SEQ / 128), F.lds, F.wave, BgStage{F.ctl + CW_BG + layer * 64, layer}, F.bid); }
            REFRAME();
            { KAP ka = KA();
              att::Args B{WSP(bf16_t, WS_PROJ), WSP(unsigned char, WS_OS), KIN(8) + layer * 128, KIN(9) + layer * 16, 0.f, 1.0f, F.ctl + CW_KMAX + layer * 64, nullptr, nullptr};
              att::attn_phase<true>(B, F.ctl + CW_Q + (layer * 2 + 1) * 64 + rep * 16, NBATCH * 2 * 4 * (SEQ / 128), F.lds, F.wave, BgStage{F.ctl + CW_BG + layer * 64, layer}, F.bid);
              att::bg_drain(F.lds, F.wave, BgStage{F.ctl + CW_BG + layer * 64, layer}); }
        PHASE_REDO(pb + 1); }
        SEAM(pb + 1);
        if (PON(3) && IN(pb + 2)) PHASE_LOOP(pb + 2) { REFRAME();
            { KAP ka = KA(); pg8::DenseSchedF8in S; S.init(WSP(unsigned char, WS_OD), WSP(unsigned char, WS_WA) + (size_t)layer * DM * DM, NTOK, DM, DM / 2, F.G, F.bid);
              pg8::EpiGate<false> E{WSP(bf16_t, WS_MG), WSP(bf16_t, WS_PROJ), COL_GA};
              pg8::gemm_phase<pg8::EpiGate<false>, pg8::DenseSchedF8in, true, true>(F.lds + RING_OFF, DM / 2, S, E, F.tid); }
            VM_WAIT(); REFRAME();
            { KAP ka = KA(); pg8::DenseSchedF8in S; S.init(WSP(unsigned char, WS_OS), WSP(unsigned char, WS_WB) + (size_t)layer * DM * DM, NTOK, DM, DM / 2, F.G, F.bid);
              pg8::EpiGate<true> E{WSP(bf16_t, WS_MG), WSP(bf16_t, WS_PROJ), COL_GB};
              pg8::gemm_phase<pg8::EpiGate<true>, pg8::DenseSchedF8in, true, true>(F.lds + RING_OFF, DM / 2, S, E, F.tid); }
        PHASE_REDO(pb + 2); }
        SEAM(pb + 2);
        if (PON(4) && IN(pb + 3)) PHASE_LOOP(pb + 3) { REFRAME();
            KAP ka = KA(); pg8::DenseSched S; S.init(WSP(bf16_t, WS_MG), WSP(bf16_t, WS_WOUT) + (size_t)layer * DM * DM, NTOK, DM, DM, F.G, F.bid);
            pg8::EpiRes E{KIN(0), (layer == 0) ? (const bf16_t*)nullptr : (const bf16_t*)WSP(bf16_t, WS_XB), WSP(bf16_t, WS_PRE), KIN(13) + layer * DM};
            pg8::gemm_phase<pg8::EpiRes, pg8::DenseSched>(F.lds + RING_OFF, DM, S, E, F.tid);
        PHASE_REDO(pb + 3); }
        SEAM(pb + 3);
        if (PON(5) && IN(pb + 4)) PHASE_LOOP(pb + 4) { REFRAME();
            KAP ka = KA();
            const bool dummy = rep + 1 < NREP(pb + 4);
            phase_ln_router(F, WSP(bf16_t, WS_PRE), KIN(14) + layer * DM, KIN(15) + layer * DM, WSP(bf16_t, WS_X1B), WSP(unsigned char, WS_X1F8), KIN(16) + (size_t)layer * DM * NEXP, KIN(17) + layer * NEXP, dummy ? F.ctl + 65536 : gcnt,
                            WSP(unsigned, dummy ? WS_Y : WS_LTOK), WSP(float, dummy ? WS_Y + 8 * MiB : WS_LGATE), WSP(int, dummy ? WS_Y + 16 * MiB : WS_TOKE), WSP(int, dummy ? WS_Y + 24 * MiB : WS_TOKP));
        PHASE_REDO(pb + 4); }
        SEAM(pb + 4);
        if (PON(6) && IN(pb + 5)) PHASE_LOOP(pb + 5) { REFRAME();
            moe_tables(F, gcnt);
            KAP ka = KA(); const unsigned* LTOK = WSP(unsigned, WS_LTOK);
            moe::Tables T;
            const int total = T.mts[NEXP] * 8;
            LAS unsigned* tokc = (LAS unsigned*)(F.lds + LC_TOKC);
#pragma unroll 1
            for (int i0 = 0; i0 < 20; i0 += 10) { unsigned tk[10];
#pragma unroll
                for (int q = 0; q < 10; ++q) { int mt, pn_; const bool ok = moe::Sched1::map(i0 + q, F.G, F.bid, total, mt, pn_); tk[q] = 0u;
                    if (ok && F.tid < 256) { const int e = moe::find_expert(T, mt); const int pos = mt * 256 + F.tid - T.offs[e]; if (pos < T.cnt[e]) tk[q] = LTOK[(unsigned)(e * LIST_CAP + pos)]; } }
#pragma unroll
                for (int q = 0; q < 10; ++q) if (F.tid < 256) tokc[(i0 + q) * 256 + F.tid] = tk[q] >> 2; }
            __syncthreads();
            moe::Sched1 S{T, (const char*)WSP(unsigned char, WS_X1F8), (const char*)(WSP(unsigned char, WS_WGU) + (size_t)layer * NEXP * 2048 * DM), tokc, F.G, F.bid, total};
            moe::EpiAct E{WSP(unsigned char, WS_ACT), KIN(19) + (size_t)layer * NEXP * 2048};
            pg8::gemm_phase<moe::EpiAct, moe::Sched1, true, true>(F.lds + RING_OFF, DM / 2, S, E, F.tid);
        PHASE_REDO(pb + 5); }
        SEAM(pb + 5);
        if (PON(7) && IN(pb + 6)) PHASE_LOOP(pb + 6) { REFRAME();
            if (MK_N_LAUNCHES != 1) moe_tables(F, gcnt);
            moe::Tables T;
            KAP ka = KA();
            moe::Sched2 S{T, (const char*)WSP(unsigned char, WS_ACT), (const char*)(WSP(unsigned char, WS_WDN) + (size_t)layer * NEXP * DM * DM), F.G >> 2, (F.G >> 5) * (F.bid & 7) + (F.bid >> 5), T.mts[NEXP], (F.bid >> 3) & 3};
            moe::EpiY E{WSP(unsigned char, WS_Y), KIN(21) + (size_t)layer * NEXP * DM, WSP(float, WS_LGATE), T};
            pg8::gemm_phase<moe::EpiY, moe::Sched2, true, true>(F.lds + RING_OFF, DM / 2, S, E, F.tid);
        PHASE_REDO(pb + 6); }
        if (PON(8) && IN(pb + 7)) PHASE_LOOP(pb + 7) { REFRAME();
            KAP ka = KA(); pg8::DenseSchedF8 S; S.init(WSP(unsigned char, WS_X1F8), WSP(unsigned char, WS_WPG8) + (size_t)layer * DM * DM, NTOK, DM, DM / 2, F.G, F.bid);
            pg8::EpiPle E{WSP(bf16_t, WS_X1B), WSP(bf16_t, WS_PRE), WSP(bf16_t, WS_TPP)};
            pg8::gemm_phase<pg8::EpiPle, pg8::DenseSchedF8, true, true>(F.lds + RING_OFF, DM / 2, S, E, F.tid);
        PHASE_REDO(pb + 7); }
        SEAM(pb + 7);
        if (PON(9) && IN(pb + 8)) PHASE_LOOP(pb + 8) { REFRAME();
            if (MK_N_LAUNCHES != 1) moe_tables(F, gcnt);
            KAP ka = KA();
            phase_combine_ln(F, WSP(bf16_t, WS_PRE), WSP(unsigned char, WS_Y), WSP(int, WS_TOKE), WSP(int, WS_TOKP), KIN(24) + layer * DM, KIN(25) + layer * DM, (layer + 1 == DEPTH) ? ka->out : (float*)nullptr, WSP(bf16_t, WS_XB), WSP(unsigned char, WS_XB8));
            VM_WAIT(); __syncthreads(); PHASE_REDO(pb + 8);
        }
        if (layer + 1 < DEPTH) SEAM(pb + 8);
    }

#undef IN
#undef SEAM
}

extern "C" void kernel_launch(void* const* d_in, const int* in_sizes, int n_in, void* d_out, int out_size, void* d_ws, size_t ws_size, hipStream_t stream) {
    static int grid = 0;
    if (grid == 0) {
        if (n_in != 26 || out_size != NTOK * DM || ws_size < WS_END) { fprintf(stderr, "kernel_launch: unexpected shapes (n_in %d, out %d, ws %zu)\n", n_in, out_size, ws_size); grid = -1; return; }
        int dev = 0, cus = 0, per_cu = 0;
        if (hipGetDevice(&dev) != hipSuccess || hipDeviceGetAttribute(&cus, hipDeviceAttributeMultiprocessorCount, dev) != hipSuccess) { grid = -1; return; }
        if (hipFuncSetAttribute((const void*)mk_fwd, hipFuncAttributeMaxDynamicSharedMemorySize, LDS_BYTES) != hipSuccess) { fprintf(stderr, "kernel_launch: hipFuncSetAttribute failed\n"); grid = -1; return; }
        if (hipOccupancyMaxActiveBlocksPerMultiprocessor(&per_cu, (const void*)mk_fwd, NWAVES * 64, LDS_BYTES) != hipSuccess || per_cu < 1) { fprintf(stderr, "kernel_launch: occupancy query says %d\n", per_cu); }
        (void)hipGetLastError();
        grid = cus - cus % 32;
    }
    if (grid < 0) return;
    if (hipMemsetAsync((char*)d_ws + WS_CTL, 0, CTL_ZERO_BYTES, stream) != hipSuccess) return;
    KArgs a{};
    for (int i = 0; i < 26; ++i) a.in[i] = (const float*)d_in[i];
    a.out = (float*)d_out; a.ws = (unsigned char*)d_ws;
    if (MK_N_LAUNCHES == 1) {
        a.ph_lo = 0; a.ph_hi = NPHASES;
        hipLaunchKernelGGL(mk_fwd, dim3(grid), dim3(NWAVES * 64), LDS_BYTES, stream, a);
    } else {
        for (int ph = 0; ph < NPHASES; ++ph) { a.ph_lo = ph; a.ph_hi = ph + 1; hipLaunchKernelGGL(mk_fwd, dim3(grid), dim3(NWAVES * 64), LDS_BYTES, stream, a); }
    }
}
```

```cpp
#include <hip/hip_runtime.h>
#include <cstdio>
#include <cstdint>

#ifndef MK_N_LAUNCHES
#define MK_N_LAUNCHES 1
#endif

#define GAS __attribute__((address_space(1)))
#define LAS __attribute__((address_space(3)))
typedef unsigned short bf16_t;
typedef short bf16x8 __attribute__((ext_vector_type(8)));
typedef short s16x4 __attribute__((ext_vector_type(4)));
typedef float f32x4 __attribute__((ext_vector_type(4)));
typedef float f32x2 __attribute__((ext_vector_type(2)));
typedef float f32x16 __attribute__((ext_vector_type(16)));
typedef unsigned u32x4 __attribute__((ext_vector_type(4)));
typedef unsigned u32x2 __attribute__((ext_vector_type(2)));
typedef int i32x4 __attribute__((ext_vector_type(4)));

constexpr int NBATCH = 2, SEQ = 16384, NTOK = NBATCH * SEQ, DM = 1024, INW = 6400, NEXP = 32, TOPK = 4, PLED = 256, DEPTH = 2;
constexpr int COL_DQ = 0, COL_DK = 1024, COL_DV = 2048, COL_SQ = 3072, COL_SK = 4096, COL_SV = 4224, COL_GA = 4352, COL_GB = 5376;
constexpr float LOG2E = 1.4426950408889634f, QSCALE = 0.125f * LOG2E, DN_ALPHA = 1.4142135623730951f;
constexpr float LN_EPS = 1e-5f, RMS_EPS = 1e-5f;
constexpr int LIST_CAP = NTOK;
constexpr int SLOTS_MAX = 139264;

constexpr size_t MiB = 1u << 20;
constexpr size_t WS_CTL = 0, CTL_ZERO_BYTES = 160 * 1024;
constexpr size_t WS_WIN = 2 * MiB, WS_WA = 27 * MiB, WS_WB = 31 * MiB, WS_WOUT = 35 * MiB, WS_WPG = 39 * MiB, WS_WPP = 43 * MiB;
constexpr size_t WS_WGU = 44 * MiB, WS_WDN = 300 * MiB;
constexpr size_t WS_XB = 428 * MiB, WS_PB = 492 * MiB, WS_PROJ = 524 * MiB, WS_ACT = WS_PROJ  ;
constexpr size_t WS_WIN8 = (1244 + 66) * MiB;
constexpr size_t WS_XB8 = (1244 + 72) * MiB;
constexpr float WING_SC = 32.0f, XIN_SC = 16.0f, ATT_OSC = 16.0f, WAB_SC = 32.0f;
constexpr int NT_PROJ = 17, NT_GATE = 8;
constexpr size_t WS_WPG8 = (1244 + 64) * MiB;
constexpr float WPGSC = 32.0f;
constexpr size_t WS_OD = 924 * MiB, WS_OS = 988 * MiB, WS_MG = 1052 * MiB, WS_PRE = 1116 * MiB, WS_X1 = 1244 * MiB, WS_X1B = 1372 * MiB;
constexpr size_t WS_Y = 1436 * MiB, WS_TPP = 1708 * MiB, WS_LTOK = 1772 * MiB, WS_LGATE = 1776 * MiB, WS_TOKE = 1780 * MiB, WS_TOKP = 1781 * MiB, WS_KIMG = 1782 * MiB, WS_VIMG = 1846 * MiB, WS_X1F8 = 1910 * MiB, WS_END = 1942 * MiB;
static_assert((size_t)SLOTS_MAX * DM * 2 <= 272 * MiB, "act / y size");
constexpr int CW_TMO = 0, CW_CODE = 1, CW_BAR = 4096, CW_Q = 8192, CW_CNT = 12288, CW_KMAX = 20480, CW_QX = 24576, CW_BG = 32768;

constexpr int RING_OFF = 0, RING_BYTES = 131072;
constexpr int LDSCTL_OFF = RING_BYTES;
constexpr int LC_MISC = LDSCTL_OFF;
constexpr int LC_CNT = LDSCTL_OFF + 256;
constexpr int LC_OFFS = LDSCTL_OFF + 512;
constexpr int LC_MTS = LDSCTL_OFF + 768;
constexpr int LC_LCNT = LDSCTL_OFF + 1024;
constexpr int LC_LOG = LDSCTL_OFF + 1536;
constexpr int LC_ENT = LDSCTL_OFF + 2560;
constexpr int LC_WSF = LDSCTL_OFF + 8704;
constexpr int LC_TOKC = LDSCTL_OFF + 10752 + 64;
constexpr int LDS_BYTES = 163840;
static_assert(LC_TOKC + 20 * 256 * 4 <= LDS_BYTES, "LDS map");

#define RLX_AGENT __ATOMIC_RELAXED, __HIP_MEMORY_SCOPE_AGENT
#define LDS_WAIT() asm volatile("s_waitcnt lgkmcnt(0)" ::: "memory")
#define VM_WAIT() asm volatile("s_waitcnt vmcnt(0)" ::: "memory")

__device__ __forceinline__ unsigned cvt_pk_bf16(float lo, float hi) { unsigned r; asm volatile("v_cvt_pk_bf16_f32 %0, %1, %2" : "=v"(r) : "v"(lo), "v"(hi)); return r; }
__device__ __forceinline__ unsigned pk4_fp8(float a, float b, float c, float d) { int w = 0; w = __builtin_amdgcn_cvt_pk_fp8_f32(a, b, w, false); w = __builtin_amdgcn_cvt_pk_fp8_f32(c, d, w, true); return (unsigned)w; }
__device__ __forceinline__ float bf_lo(unsigned u) { return __uint_as_float(u << 16); }
__device__ __forceinline__ float bf_hi(unsigned u) { return __uint_as_float(u & 0xffff0000u); }
__device__ __forceinline__ float sigmoidf_(float x) { return __builtin_amdgcn_rcpf(1.0f + __builtin_amdgcn_exp2f(-x * LOG2E)); }
__device__ __forceinline__ float dpp_xor1(float v) { return __builtin_bit_cast(float, __builtin_amdgcn_update_dpp(0, __builtin_bit_cast(int, v), 0xB1, 0xf, 0xf, true)); }
__device__ __forceinline__ float dpp_xor2(float v) { return __builtin_bit_cast(float, __builtin_amdgcn_update_dpp(0, __builtin_bit_cast(int, v), 0x4E, 0xf, 0xf, true)); }
__device__ __forceinline__ float shx(float v, int m, int lane) { return __builtin_bit_cast(float, __builtin_amdgcn_ds_bpermute((lane ^ m) << 2, __builtin_bit_cast(int, v))); }
__device__ __forceinline__ float wave_sum(float v, int lane) {
#pragma unroll
    for (int o = 1; o < 64; o <<= 1) v += shx(v, o, lane);
    return v;
}

namespace pg8 {
#define PG8_LAS __attribute__((address_space(3)))
constexpr int BM = 256, BK = 64, HALF = 128, HTB = HALF * BK * 2, STAGE_BYTES = 8 * HTB, NXCD = 8, WGM = 8;
__host__ __device__ __forceinline__ int lds_byte(int r, int c) { const int st = (r >> 4) * 2 + (c >> 5), rr = r & 15, cc = c & 31, ob = rr * 64 + cc * 2; return st * 1024 + (ob ^ (((ob >> 9) & 1) << 5)); }
__host__ __device__ __forceinline__ void stage_rc(int b, int& R, int& C) { const int st = b / 1024, sb = b % 1024, swz = sb ^ (((sb >> 9) & 1) << 5); R = (st >> 1) * 16 + swz / 64; C = (st & 1) * 32 + (swz % 64) / 2; }
__host__ __device__ __forceinline__ int perm32(int rho) { const int n = rho >> 4, i = rho & 15; return 8 * (i >> 2) + 4 * n + (i & 3); }

struct Unit { int pm, pn, ex; };

struct DenseSched {
    static constexpr bool UNIT_OFFS = false; static constexpr int SCALE_A = 0x7F7F7F7F, SCALE_B = 0x7F7F7F7F;
    const char* A; const char* Bt; int K; int nM, nN, nwg, G, c;
    __device__ void init(const void* A_, const void* Bt_, int M, int N, int K_, int G_, int c_) { A = (const char*)A_; Bt = (const char*)Bt_; K = K_; nM = M / BM; nN = N / BM; nwg = nM * nN; G = G_; c = c_; }
    __device__ __forceinline__ bool next(int i, Unit& u) const {
        const long L = (long)i * G + c; if (L >= nwg) return false;
        int wgid = (int)L; { const int q = nwg / NXCD, r = nwg % NXCD, xcd = wgid % NXCD, off = wgid / NXCD; wgid = (xcd < r ? xcd * (q + 1) : r * (q + 1) + (xcd - r) * q) + off; }
        const int nig = WGM * nN, gid = wgid / nig, fm = gid * WGM, gsz = (nM - fm) < WGM ? (nM - fm) : WGM;
        u.pm = fm + ((wgid % nig) % gsz); u.pn = (wgid % nig) / gsz; u.ex = 0; return true;
    }
    __device__ __forceinline__ const char* a_base(const Unit& u) const { return A + (size_t)u.pm * BM * K * 2; }
    __device__ __forceinline__ void a_offs(const Unit&, const int (&R)[2], const int (&C)[2], unsigned (&off)[2][2]) const {
#pragma unroll
        for (int h = 0; h < 2; ++h)
#pragma unroll
            for (int i = 0; i < 2; ++i) off[h][i] = (unsigned)((h * HALF + R[i]) * K + C[i]) * 2u;
    }
    __device__ __forceinline__ const char* b_base(const Unit& u, int h) const { return Bt + ((size_t)u.pn * BM + h * HALF) * K * 2; }
};

struct DenseSchedF8 : DenseSched { static constexpr int SCALE_A = 0x7D7D7D7D, SCALE_B = 0x7A7A7A7A; };
struct DenseSchedF8in : DenseSched { static constexpr int SCALE_A = 0x7B7B7B7B, SCALE_B = 0x7A7A7A7A;
    int nl = 0, cntL = 0, cntS = 0;
    __device__ __forceinline__ bool next(int i, Unit& u) const {
        if (nl == 0) return DenseSched::next(i, u);
        int L; if (c < nl) { if (i >= cntL) return false; L = i * nl + c; } else { if (i >= cntS) return false; L = nl * cntL + i * (G - nl) + (c - nl); }
        int wgid = L; { const int q = nwg / NXCD, r = nwg % NXCD, xcd = wgid % NXCD, off = wgid / NXCD; wgid = (xcd < r ? xcd * (q + 1) : r * (q + 1) + (xcd - r) * q) + off; }
        const int nig = WGM * nN, gid = wgid / nig, fm = gid * WGM, gsz = (nM - fm) < WGM ? (nM - fm) : WGM;
        u.pm = fm + ((wgid % nig) % gsz); u.pn = (wgid % nig) / gsz; u.ex = 0; return true;
    }
};
template <class Epi, class Sched, bool ALIGN_EPI = true, bool FP8 = false>
__device__ __forceinline__ void gemm_phase(PG8_LAS unsigned char* lds, const int K, const Sched& S, const Epi& E, const int tid  ) {
    const int wid = __builtin_amdgcn_readfirstlane(tid >> 6), lane = tid & 63, wr = wid >> 2, wc = wid & 3, fr = lane & 15, fq = lane >> 4;
    const int nt = K / BK;
    int R[2], C[2]; unsigned voffB[2];
#pragma unroll
    for (int i = 0; i < 2; ++i) { stage_rc(tid * 16 + i * 8192, R[i], C[i]); const int Rb = Epi::PERM ? ((R[i] & ~31) + perm32(R[i] & 31)) : R[i]; voffB[i] = (unsigned)(Rb * K + C[i]) * 2u; }
    const unsigned kstep = (unsigned)(BK * 2);
    const unsigned ldsw = (unsigned)wid * 1024u;
    const int aoff = lds_byte(wr * 64 + fr, fq * 8), boff = lds_byte(wc * 32 + fr, fq * 8);
#define PG8_SA(b, h) (((b) * 2 + (h)) * HTB)
#define PG8_SB(b, h) ((4 + (b) * 2 + (h)) * HTB)
#define PG8_GLDS(sbase_, voff_, ldsdst_) do { unsigned keep_; asm volatile("s_mov_b32 %0, m0\n\ts_mov_b32 m0, %3\n\ts_nop 0\n\tglobal_load_lds_dwordx4 %1, %2\n\ts_mov_b32 m0, %0" \
        : "=&s"(keep_) : "v"(voff_), "s"(sbase_), "s"(ldsdst_) : "memory"); } while (0)
    const unsigned ldsbase = (unsigned)(uintptr_t)lds + ldsw;
#define PG8_STAGE_A(bufoff, h, base, offs, kb) do { const char* _b = (base) + (kb); _Pragma("unroll") for (int _i = 0; _i < 2; ++_i) \
        PG8_GLDS(_b, (offs)[h][_i], (unsigned)__builtin_amdgcn_readfirstlane(ldsbase + (bufoff) + _i * 8192)); } while (0)
#define PG8_STAGE_B(bufoff, base, kb) do { const char* _b = (base) + (kb); _Pragma("unroll") for (int _i = 0; _i < 2; ++_i) \
        PG8_GLDS(_b, voffB[_i], (unsigned)__builtin_amdgcn_readfirstlane(ldsbase + (bufoff) + _i * 8192)); } while (0)
#define PG8_LDA(dst, b, h) do { _Pragma("unroll") for (int m = 0; m < 4; ++m) _Pragma("unroll") for (int k = 0; k < 2; ++k) dst[m][k] = *(const PG8_LAS bf16x8*)(lds + PG8_SA(b, h) + aoff + m * 2048 + k * 1024); } while (0)
#define PG8_LDB(dst, b, h) do { _Pragma("unroll") for (int n = 0; n < 2; ++n) _Pragma("unroll") for (int k = 0; k < 2; ++k) dst[n][k] = *(const PG8_LAS bf16x8*)(lds + PG8_SB(b, h) + boff + n * 2048 + k * 1024); } while (0)
#define PG8_MMA(ai, bj, At, Bt) do { __builtin_amdgcn_s_setprio(1); _Pragma("unroll") for (int m = 0; m < 4; ++m) _Pragma("unroll") for (int n = 0; n < 2; ++n) { \
        if constexpr (FP8) { acc[ai][bj][m][n] = __builtin_amdgcn_mfma_scale_f32_16x16x128_f8f6f4(__builtin_shufflevector(__builtin_bit_cast(i32x4, Bt[n][0]), __builtin_bit_cast(i32x4, Bt[n][1]), 0, 1, 2, 3, 4, 5, 6, 7), \
                __builtin_shufflevector(__builtin_bit_cast(i32x4, At[m][0]), __builtin_bit_cast(i32x4, At[m][1]), 0, 1, 2, 3, 4, 5, 6, 7), acc[ai][bj][m][n], 0, 0, 0, Sched::SCALE_B, 0, Sched::SCALE_A); } \
        else { _Pragma("unroll") for (int k = 0; k < 2; ++k) acc[ai][bj][m][n] = __builtin_amdgcn_mfma_f32_16x16x32_bf16(Bt[n][k], At[m][k], acc[ai][bj][m][n], 0, 0, 0); } } \
        __builtin_amdgcn_s_setprio(0); } while (0)
#define PG8_WAIT_V(n) asm volatile("s_waitcnt vmcnt(" #n ")" ::: "memory")
#define PG8_WAIT_L(n) asm volatile("s_waitcnt lgkmcnt(" #n ")" ::: "memory")
#define PG8_BAR __builtin_amdgcn_s_barrier()
#define PG8_SCHED __builtin_amdgcn_sched_barrier(0)
    Unit cur, nxt; int ui = 0;
    if (!S.next(0, cur)) return;
    f32x4 acc[2][2][4][2];
#pragma unroll
    for (int a = 0; a < 2; ++a)
#pragma unroll
        for (int b = 0; b < 2; ++b)
#pragma unroll
            for (int m = 0; m < 4; ++m)
#pragma unroll
                for (int n = 0; n < 2; ++n) acc[a][b][m][n] = (f32x4){0.f, 0.f, 0.f, 0.f};
    bf16x8 At[4][2], B0[2][2], B1[2][2];
    unsigned coff[2][2];
    S.a_offs(cur, R, C, coff);
    const char* cA = S.a_base(cur); const char* cB0 = S.b_base(cur, 0); const char* cB1 = S.b_base(cur, 1);
    PG8_STAGE_B(PG8_SB(0, 0), cB0, 0u); PG8_STAGE_B(PG8_SB(0, 1), cB1, 0u); PG8_STAGE_A(PG8_SA(0, 0), 0, cA, coff, 0u); PG8_STAGE_A(PG8_SA(0, 1), 1, cA, coff, 0u);
    if (wr == 1) PG8_BAR;
    PG8_WAIT_V(2); PG8_BAR;
    PG8_STAGE_B(PG8_SB(1, 0), cB0, kstep); PG8_STAGE_A(PG8_SA(1, 0), 0, cA, coff, kstep); PG8_STAGE_B(PG8_SB(1, 1), cB1, kstep);
    PG8_WAIT_V(6); PG8_BAR;
    for (;;) {
        const bool has_next = S.next(ui + 1, nxt);
        const char* nA = cA; const char* nB0 = cB0; const char* nB1 = cB1;
        if (has_next) { nA = S.a_base(nxt); nB0 = S.b_base(nxt, 0); nB1 = S.b_base(nxt, 1); }
#pragma unroll 1
        for (int t = 0; t < nt; t += 2) {
            const bool last = (t == nt - 2);
            const unsigned a1k = (unsigned)(t + 1) * kstep;
            const char* a2 = last ? nA : cA; const char* b20 = last ? nB0 : cB0; const char* b21 = last ? nB1 : cB1;
            const unsigned a2k = last ? 0u : (unsigned)(t + 2) * kstep, a3k = a2k + kstep;
            PG8_LDB(B0, 0, 0); PG8_LDB(B1, 0, 1); PG8_SCHED; PG8_LDA(At, 0, 0); PG8_STAGE_A(PG8_SA(1, 1), 1, cA, coff, a1k);
            if (Sched::UNIT_OFFS) { if (last && has_next) S.a_offs(nxt, R, C, coff); }
            PG8_WAIT_V(8); PG8_WAIT_L(0); PG8_BAR; PG8_MMA(0, 0, At, B0); PG8_MMA(0, 1, At, B1); PG8_BAR; PG8_SCHED;
            PG8_LDA(At, 0, 1); PG8_STAGE_B(PG8_SB(0, 0), b20, a2k); PG8_STAGE_B(PG8_SB(0, 1), b21, a2k); PG8_STAGE_A(PG8_SA(0, 0), 0, a2, coff, a2k);
            PG8_WAIT_V(8); PG8_WAIT_L(0); PG8_BAR; PG8_MMA(1, 0, At, B0); PG8_MMA(1, 1, At, B1); PG8_BAR; PG8_SCHED;
            PG8_LDB(B0, 1, 0); PG8_LDB(B1, 1, 1); PG8_SCHED; PG8_LDA(At, 1, 0); PG8_STAGE_A(PG8_SA(0, 1), 1, a2, coff, a2k);
            PG8_WAIT_V(8); PG8_WAIT_L(0); PG8_BAR; PG8_MMA(0, 0, At, B0); PG8_MMA(0, 1, At, B1); PG8_BAR; PG8_SCHED;
            PG8_LDA(At, 1, 1); PG8_STAGE_B(PG8_SB(1, 0), b20, a3k); PG8_STAGE_B(PG8_SB(1, 1), b21, a3k); PG8_STAGE_A(PG8_SA(1, 0), 0, a2, coff, a3k);
            PG8_WAIT_V(8); PG8_WAIT_L(0); PG8_BAR; PG8_MMA(1, 0, At, B0); PG8_MMA(1, 1, At, B1); PG8_BAR; PG8_SCHED;
        }
        if constexpr (ALIGN_EPI) { if (wr == 0) PG8_BAR; }
        { int le_; asm volatile("v_mbcnt_lo_u32_b32 %0, -1, 0\n\tv_mbcnt_hi_u32_b32 %0, -1, %0" : "=v"(le_));
          E(acc, cur, wr, wc, le_ & 15, le_ >> 4); }
        if (!has_next) break;
#pragma unroll
        for (int a = 0; a < 2; ++a)
#pragma unroll
            for (int b = 0; b < 2; ++b)
#pragma unroll
                for (int m = 0; m < 4; ++m)
#pragma unroll
                    for (int n = 0; n < 2; ++n) acc[a][b][m][n] = (f32x4){0.f, 0.f, 0.f, 0.f};
        cur = nxt; cA = nA; cB0 = nB0; cB1 = nB1; ++ui;
        if constexpr (ALIGN_EPI) { if (wr == 1) PG8_BAR; }
    }
    PG8_WAIT_V(0);
    if constexpr (!ALIGN_EPI) { if (wr == 0) PG8_BAR; }
    PG8_BAR;
#undef PG8_SA
#undef PG8_SB
#undef PG8_STAGE_A
#undef PG8_GLDS
#undef PG8_STAGE_B
#undef PG8_LDA
#undef PG8_LDB
#undef PG8_MMA
#undef PG8_WAIT_V
#undef PG8_WAIT_L
#undef PG8_BAR
#undef PG8_SCHED
}

typedef f32x4 Acc[2][2][4][2];

struct EpiProj {
    static constexpr bool PERM = true;
    bf16_t* O; int ldc; const float* bias; bool qscale; unsigned* kmax; bf16_t* kimg; bf16_t* vimg; int pn0  ;
    __device__ __forceinline__ void operator()(const Acc& acc, const Unit& u, int wr, int wc, int fr, int fq) const {
        const int row0 = u.pm * BM + wr * 64 + fr, col0 = (u.pn + pn0) * BM + wc * 32 + 8 * fq;
        const float sc = (qscale && (u.pn < 4 || (u.pn >= 12 && u.pn < 16))) ? QSCALE : 1.f;
        const bool dok = kmax != nullptr && u.pn >= 4 && u.pn < 8; float km[2] = {0.f, 0.f}; const int lane = fq * 16 + fr;
        const bool isk = kimg != nullptr && u.pn >= 4 && u.pn < 8, isv = kimg != nullptr && u.pn >= 8 && u.pn < 12;
        const unsigned bb = (unsigned)(u.pm >> 6) * (8u * 256u * 8192u); const int ktb = (u.pm & 63) * 4 + wr;
        const int kin = (wc >> 1) * 4096 + ((wc & 1) * 4 + fq) * 512 + fr * 8, vin = wc * 2048 + fr * 32 + 8 * fq;
        f32x4 bv[2][2];
#pragma unroll
        for (int bj = 0; bj < 2; ++bj)
#pragma unroll
            for (int n = 0; n < 2; ++n) bv[bj][n] = bias ? *(const f32x4*)(bias + col0 + bj * HALF + 4 * n) : (f32x4){0.f, 0.f, 0.f, 0.f};
#pragma unroll
        for (int ai = 0; ai < 2; ++ai)
#pragma unroll
            for (int m = 0; m < 4; ++m) { char* rowp = (char*)O + 2u * ((unsigned)(row0 + ai * HALF + m * 16) * (unsigned)ldc + (unsigned)col0);
#pragma unroll
                for (int bj = 0; bj < 2; ++bj) { f32x4 v0 = (acc[ai][bj][m][0] + bv[bj][0]) * sc, v1 = (acc[ai][bj][m][1] + bv[bj][1]) * sc;
                    u32x4 w; w.x = cvt_pk_bf16(v0[0], v0[1]); w.y = cvt_pk_bf16(v0[2], v0[3]); w.z = cvt_pk_bf16(v1[0], v1[1]); w.w = cvt_pk_bf16(v1[2], v1[3]);
                    if (isk) __builtin_nontemporal_store(w, (u32x4*)((char*)kimg + 2u * (bb + (unsigned)(((u.pn - 4) * 2 + bj) * 256 + ktb + 2 * ai) * 8192u + (unsigned)(kin + m * 128))));
                    else if (isv) __builtin_nontemporal_store(w, (u32x4*)((char*)vimg + 2u * (bb + (unsigned)(((u.pn - 8) * 2 + bj) * 256 + ktb + 2 * ai) * 8192u + (unsigned)(vin + m * 512))));
                    else __builtin_nontemporal_store(w, (u32x4*)(rowp + 2 * bj * HALF));
                    if (dok) { float ss = bf_lo(w.x) * bf_lo(w.x) + bf_hi(w.x) * bf_hi(w.x) + bf_lo(w.y) * bf_lo(w.y) + bf_hi(w.y) * bf_hi(w.y) + bf_lo(w.z) * bf_lo(w.z) + bf_hi(w.z) * bf_hi(w.z) + bf_lo(w.w) * bf_lo(w.w) + bf_hi(w.w) * bf_hi(w.w);
                        ss += shx(ss, 16, lane); ss += shx(ss, 32, lane); km[bj] = fmaxf(km[bj], ss); } } }
        if (dok) {
#pragma unroll
            for (int bj = 0; bj < 2; ++bj) { float v = km[bj];
#pragma unroll
                for (int o = 1; o < 16; o <<= 1) v = fmaxf(v, shx(v, o, lane));
                v *= 1.0001f;
                if (lane == 0) __hip_atomic_fetch_max(kmax + (u.pm >= (NTOK / 2) / BM ? 32 : 0) + (u.pn - 4) * 8 + bj * 4 + wc, __float_as_uint(v), RLX_AGENT); }
        }
    }
};
template <bool ADD> struct EpiGate {
    static constexpr bool PERM = true;
    bf16_t* O; const bf16_t* G; int gcol;
    __device__ __forceinline__ void operator()(const Acc& acc, const Unit& u, int wr, int wc, int fr, int fq) const {
        const int row0 = u.pm * BM + wr * 64 + fr, col0 = u.pn * BM + wc * 32 + 8 * fq;
#pragma unroll
        for (int ai = 0; ai < 2; ++ai)
#pragma unroll
            for (int mp = 0; mp < 2; ++mp)
#pragma unroll
            for (int bj = 0; bj < 2; ++bj) {
                u32x4 gg[2], tt[2];
#pragma unroll
                for (int mm = 0; mm < 2; ++mm) { const unsigned row = (unsigned)(row0 + ai * HALF + (mp * 2 + mm) * 16);
                    gg[mm] = *(const u32x4*)((const char*)G + 2u * (row * (unsigned)INW + (unsigned)(gcol + col0 + bj * HALF)));
                    tt[mm] = ADD ? *(const u32x4*)((const char*)O + 2u * (row * (unsigned)DM + (unsigned)(col0 + bj * HALF))) : (u32x4){0u, 0u, 0u, 0u}; }
#pragma unroll
                for (int mm = 0; mm < 2; ++mm) { const int m = mp * 2 + mm; const unsigned row = (unsigned)(row0 + ai * HALF + m * 16);
                    const u32x4 g = gg[mm], t = tt[mm]; char* op = (char*)O + 2u * (row * (unsigned)DM + (unsigned)(col0 + bj * HALF));
                    const f32x4 a0 = acc[ai][bj][m][0], a1 = acc[ai][bj][m][1];
                    float r[8];
                    r[0] = sigmoidf_(bf_lo(g.x)) * a0[0]; r[1] = sigmoidf_(bf_hi(g.x)) * a0[1]; r[2] = sigmoidf_(bf_lo(g.y)) * a0[2]; r[3] = sigmoidf_(bf_hi(g.y)) * a0[3];
                    r[4] = sigmoidf_(bf_lo(g.z)) * a1[0]; r[5] = sigmoidf_(bf_hi(g.z)) * a1[1]; r[6] = sigmoidf_(bf_lo(g.w)) * a1[2]; r[7] = sigmoidf_(bf_hi(g.w)) * a1[3];
                    if (ADD) { r[0] += bf_lo(t.x); r[1] += bf_hi(t.x); r[2] += bf_lo(t.y); r[3] += bf_hi(t.y); r[4] += bf_lo(t.z); r[5] += bf_hi(t.z); r[6] += bf_lo(t.w); r[7] += bf_hi(t.w); }
                    u32x4 w; w.x = cvt_pk_bf16(r[0], r[1]); w.y = cvt_pk_bf16(r[2], r[3]); w.z = cvt_pk_bf16(r[4], r[5]); w.w = cvt_pk_bf16(r[6], r[7]);
                    *(u32x4*)op = w; }
            }
    }
};
struct EpiRes {
    static constexpr bool PERM = true;
    const float* Xf; const bf16_t* Xb; bf16_t* O; const float* bias;
    __device__ __forceinline__ void operator()(const Acc& acc, const Unit& u, int wr, int wc, int fr, int fq) const {
        float alpha_; asm volatile("s_mov_b32 %0, 0x3fb504f3" : "=s"(alpha_));
        const int row0 = u.pm * BM + wr * 64 + fr, col0 = u.pn * BM + wc * 32 + 8 * fq;
        f32x4 bv[2][2];
#pragma unroll
        for (int bj = 0; bj < 2; ++bj)
#pragma unroll
            for (int n = 0; n < 2; ++n) bv[bj][n] = *(const f32x4*)(bias + col0 + bj * HALF + 4 * n);
#pragma unroll
        for (int ai = 0; ai < 2; ++ai)
#pragma unroll
            for (int mp = 0; mp < 2; ++mp) {
                f32x4 x0[2][2], x1[2][2];
#pragma unroll
                for (int mm = 0; mm < 2; ++mm)
#pragma unroll
                    for (int bj = 0; bj < 2; ++bj) { const unsigned off = (unsigned)(row0 + ai * HALF + (mp * 2 + mm) * 16) * (unsigned)DM + (unsigned)(col0 + bj * HALF);
                        if (Xb) { const u32x4 xx = *(const u32x4*)((const char*)Xb + 2u * off); x0[mm][bj] = (f32x4){bf_lo(xx.x), bf_hi(xx.x), bf_lo(xx.y), bf_hi(xx.y)}; x1[mm][bj] = (f32x4){bf_lo(xx.z), bf_hi(xx.z), bf_lo(xx.w), bf_hi(xx.w)}; }
                        else { x0[mm][bj] = *(const f32x4*)((const char*)Xf + 4u * off); x1[mm][bj] = *(const f32x4*)((const char*)Xf + 4u * off + 16); } }
#pragma unroll
                for (int mm = 0; mm < 2; ++mm)
#pragma unroll
                    for (int bj = 0; bj < 2; ++bj) { const int m = mp * 2 + mm; const unsigned off = (unsigned)(row0 + ai * HALF + m * 16) * (unsigned)DM + (unsigned)(col0 + bj * HALF);
                        const f32x4 v0 = x0[mm][bj] * alpha_ + acc[ai][bj][m][0] + bv[bj][0], v1 = x1[mm][bj] * alpha_ + acc[ai][bj][m][1] + bv[bj][1];
                        u32x4 w; w.x = cvt_pk_bf16(v0[0], v0[1]); w.y = cvt_pk_bf16(v0[2], v0[3]); w.z = cvt_pk_bf16(v1[0], v1[1]); w.w = cvt_pk_bf16(v1[2], v1[3]);
                        *(u32x4*)((char*)O + 2u * off) = w; }
            }
    }
};
struct EpiPle {
    static constexpr bool PERM = true;
    const bf16_t* X1; bf16_t* O; const bf16_t* TPP;
    __device__ __forceinline__ void operator()(const Acc& acc, const Unit& u, int wr, int wc, int fr, int fq) const {
        float alpha_; asm volatile("s_mov_b32 %0, 0x3fb504f3" : "=s"(alpha_));
        const int row0 = u.pm * BM + wr * 64 + fr, col0 = u.pn * BM + wc * 32 + 8 * fq;
#pragma unroll
        for (int ai = 0; ai < 2; ++ai)
#pragma unroll
            for (int mp = 0; mp < 2; ++mp) {
                u32x4 xs[2][2], ts[2][2];
#pragma unroll
                for (int mm = 0; mm < 2; ++mm)
#pragma unroll
                    for (int bj = 0; bj < 2; ++bj) { const unsigned off = (unsigned)(row0 + ai * HALF + (mp * 2 + mm) * 16) * (unsigned)DM + (unsigned)(col0 + bj * HALF); xs[mm][bj] = *(const u32x4*)((const char*)X1 + 2u * off); ts[mm][bj] = *(const u32x4*)((const char*)TPP + 2u * off); }
#pragma unroll
                for (int mm = 0; mm < 2; ++mm)
#pragma unroll
                    for (int bj = 0; bj < 2; ++bj) { const int m = mp * 2 + mm; const unsigned off = (unsigned)(row0 + ai * HALF + m * 16) * (unsigned)DM + (unsigned)(col0 + bj * HALF);
                        const u32x4 xx = xs[mm][bj], tp = ts[mm][bj]; const f32x4 a0 = acc[ai][bj][m][0], a1 = acc[ai][bj][m][1]; float r[8];
                        r[0] = bf_lo(xx.x) * alpha_ + sigmoidf_(a0[0]) * bf_lo(tp.x); r[1] = bf_hi(xx.x) * alpha_ + sigmoidf_(a0[1]) * bf_hi(tp.x);
                        r[2] = bf_lo(xx.y) * alpha_ + sigmoidf_(a0[2]) * bf_lo(tp.y); r[3] = bf_hi(xx.y) * alpha_ + sigmoidf_(a0[3]) * bf_hi(tp.y);
                        r[4] = bf_lo(xx.z) * alpha_ + sigmoidf_(a1[0]) * bf_lo(tp.z); r[5] = bf_hi(xx.z) * alpha_ + sigmoidf_(a1[1]) * bf_hi(tp.z);
                        r[6] = bf_lo(xx.w) * alpha_ + sigmoidf_(a1[2]) * bf_lo(tp.w); r[7] = bf_hi(xx.w) * alpha_ + sigmoidf_(a1[3]) * bf_hi(tp.w);
                        u32x4 w; w.x = cvt_pk_bf16(r[0], r[1]); w.y = cvt_pk_bf16(r[2], r[3]); w.z = cvt_pk_bf16(r[4], r[5]); w.w = cvt_pk_bf16(r[6], r[7]);
                        *(u32x4*)((char*)O + 2u * off) = w; }
            }
    }
};
}

namespace moe {
using pg8::Unit; using pg8::BM; using pg8::HALF; using pg8::Acc;
struct TabPtr { int base; __device__ __forceinline__ int operator[](int i) const { return *(const LAS int*)(uintptr_t)(unsigned)(base + 4 * i); } };
struct Tables { static constexpr TabPtr cnt{LC_CNT}, offs{LC_OFFS}, mts{LC_MTS}; };
__device__ __forceinline__ int find_expert(const Tables& T, int mt) { int e = 0;
#pragma unroll
    for (int j = 1; j < NEXP; ++j) e += (T.mts[j] <= mt) ? 1 : 0;
    return __builtin_amdgcn_readfirstlane(e); }
constexpr float XSC = 4.0f, WGUSC = 32.0f, ACTSC = 4.0f, WDNSC = 64.0f, YSC = 32.0f;
struct Sched1 {
    static constexpr bool UNIT_OFFS = true; static constexpr int SCALE_A = 0x7D7D7D7D  , SCALE_B = 0x7A7A7A7A  ;
    Tables T; const char* X1B  ; const char* WguT  ; const LAS unsigned* tokc; int G, c, total;
    static __device__ __forceinline__ bool map(int i, int G, int c, int total, int& pm, int& pn) {
        const int x = c & 7, j = c >> 3; pm = (G >> 3) * i + (G >> 5) * (x & 3) + (j >> 2); pn = 4 * (x >> 2) + (j & 3); return pm * 8 < total; }
    __device__ __forceinline__ bool next(int i, Unit& u) const { if (!map(i, G, c, total, u.pm, u.pn)) return false; u.ex = find_expert(T, u.pm) | (i << 8); return true; }
    __device__ __forceinline__ const char* a_base(const Unit&) const { return X1B; }
    __device__ __forceinline__ void a_offs(const Unit& u, const int (&R)[2], const int (&C)[2], unsigned (&off)[2][2]) const {
        const int ui = u.ex >> 8;
#pragma unroll
        for (int h = 0; h < 2; ++h)
#pragma unroll
            for (int i = 0; i < 2; ++i) off[h][i] = tokc[ui * 256 + h * HALF + R[i]] * (unsigned)DM + (unsigned)C[i] * 2u;
    }
    __device__ __forceinline__ const char* b_base(const Unit& u, int h) const { const int e = u.ex & 255; return WguT + ((size_t)e * 2048 + h * 1024 + u.pn * HALF) * DM; }
};
struct Sched2 {
    static constexpr bool UNIT_OFFS = false; static constexpr int SCALE_A = 0x7D7D7D7D  , SCALE_B = 0x79797979  ;
    Tables T; const char* ACT  ; const char* WdnT  ; int G, c, total, pn;
    __device__ __forceinline__ bool next(int i, Unit& u) const { u.pm = G * i + c; u.pn = pn; if (u.pm >= total) return false; u.ex = find_expert(T, u.pm); return true; }
    __device__ __forceinline__ const char* a_base(const Unit& u) const { return ACT + (size_t)u.pm * BM * DM; }
    __device__ __forceinline__ void a_offs(const Unit&, const int (&R)[2], const int (&C)[2], unsigned (&off)[2][2]) const {
#pragma unroll
        for (int h = 0; h < 2; ++h)
#pragma unroll
            for (int i = 0; i < 2; ++i) off[h][i] = (unsigned)((h * HALF + R[i]) * DM) + (unsigned)C[i] * 2u;
    }
    __device__ __forceinline__ const char* b_base(const Unit& u, int h) const { return WdnT + ((size_t)u.ex * 1024 + u.pn * BM + h * HALF) * DM; }
};
struct EpiAct {
    static constexpr bool PERM = true;
    unsigned char* ACT  ; const float* bgu  ;
    __device__ __forceinline__ void operator()(const Acc& acc, const Unit& u, int wr, int wc, int fr, int fq) const {
        constexpr float C1 = -1.702f * LOG2E;
        const int e = u.ex & 255; const int row0 = u.pm * BM + wr * 64 + fr, colh = wc * 32 + 8 * fq, col0 = u.pn * HALF + colh;
        const float* bg = bgu + (size_t)e * 2048 + col0; f32x2 bgc[4], bg4[4], bu1[4];
#pragma unroll
        for (int n = 0; n < 2; ++n) { const f32x4 g4_ = *(const f32x4*)(bg + 4 * n), u4_ = *(const f32x4*)(bg + 1024 + 4 * n);
            bgc[2 * n] = (f32x2){g4_[0], g4_[1]} * C1; bgc[2 * n + 1] = (f32x2){g4_[2], g4_[3]} * C1; bg4[2 * n] = (f32x2){g4_[0], g4_[1]} * ACTSC; bg4[2 * n + 1] = (f32x2){g4_[2], g4_[3]} * ACTSC;
            bu1[2 * n] = (f32x2){u4_[0], u4_[1]} + 1.0f; bu1[2 * n + 1] = (f32x2){u4_[2], u4_[3]} + 1.0f; }
#pragma unroll
        for (int ai = 0; ai < 2; ++ai)
#pragma unroll
            for (int m = 0; m < 4; ++m) { f32x2 r[4];
#pragma unroll
                for (int p = 0; p < 4; ++p) { const int n = p >> 1, j = (p & 1) * 2;
                    const f32x2 ag = (f32x2){acc[ai][0][m][n][j], acc[ai][0][m][n][j + 1]}, au = (f32x2){acc[ai][1][m][n][j], acc[ai][1][m][n][j + 1]};
                    f32x2 arg = ag * C1 + bgc[p]; arg.x = fmaxf(arg.x, 7.0f * C1); arg.y = fmaxf(arg.y, 7.0f * C1);
                    f32x2 g4 = ag * ACTSC + bg4[p]; g4.x = fminf(g4.x, 7.0f * ACTSC); g4.y = fminf(g4.y, 7.0f * ACTSC);
                    f32x2 u1 = au + bu1[p]; u1.x = __builtin_amdgcn_fmed3f(u1.x, -6.0f, 8.0f); u1.y = __builtin_amdgcn_fmed3f(u1.y, -6.0f, 8.0f);
                    f32x2 ex; ex.x = __builtin_amdgcn_exp2f(arg.x); ex.y = __builtin_amdgcn_exp2f(arg.y);
                    const f32x2 dn = ex + 1.0f; f32x2 rc; rc.x = __builtin_amdgcn_rcpf(dn.x); rc.y = __builtin_amdgcn_rcpf(dn.y);
                    r[p] = (g4 * rc) * u1; }
                u32x2 w; w.x = pk4_fp8(r[0].x, r[0].y, r[1].x, r[1].y); w.y = pk4_fp8(r[2].x, r[2].y, r[3].x, r[3].y);
                *(u32x2*)(ACT + ((unsigned)(row0 + ai * HALF + m * 16) * (unsigned)DM + (unsigned)col0)) = w; }
    }
};
struct EpiY {
    static constexpr bool PERM = true;
    unsigned char* Y  ; const float* bdn  ; const float* lgate  ; Tables T;
    __device__ __forceinline__ void operator()(const Acc& acc, const Unit& u, int wr, int wc, int fr, int fq) const {
        const int e = u.ex; const int row0 = u.pm * BM + wr * 64 + fr, col0 = u.pn * BM + wc * 32 + 8 * fq;
        const int base = T.offs[e], cnt = T.cnt[e];
#pragma unroll
        for (int bj = 0; bj < 2; ++bj) {
            const f32x4 b0 = *(const f32x4*)(bdn + (size_t)e * DM + col0 + bj * HALF), b1 = *(const f32x4*)(bdn + (size_t)e * DM + col0 + bj * HALF + 4);
#pragma unroll
            for (int ai = 0; ai < 2; ++ai)
#pragma unroll
                for (int m = 0; m < 4; ++m) { const int row = row0 + ai * HALF + m * 16; const int pos = row - base; const float g = (pos < cnt) ? lgate[(unsigned)(e * LIST_CAP + pos)] * YSC : 0.f;
                    const f32x4 v0 = (acc[ai][bj][m][0] + b0) * g, v1 = (acc[ai][bj][m][1] + b1) * g;
                    u32x2 w; w.x = pk4_fp8(v0[0], v0[1], v0[2], v0[3]); w.y = pk4_fp8(v1[0], v1[1], v1[2], v1[3]);
                    *(u32x2*)(Y + ((unsigned)row * (unsigned)DM + (unsigned)(col0 + bj * HALF))) = w; }
        }
    }
};
}

namespace att {
#ifndef PINGPONG
#define PINGPONG 0
#endif
#ifndef ATT_SB
#define ATT_SB 0
#endif
constexpr int PITCH = INW;
constexpr int KSLOT = 16384, VSLOT = 16384, NSLOT = 4, LDS_K = 0, LDS_V = NSLOT * KSLOT;
constexpr int OST = 132;
__device__ __forceinline__ int crow(int r, int hi) { return (r & 3) + 8 * (r >> 2) + 4 * hi; }
__device__ __forceinline__ void glds16(const void* gsrc, unsigned lds_dst) { unsigned keep;
    asm volatile("s_mov_b32 %0, m0\n\ts_mov_b32 m0, %2\n\ts_nop 0\n\tglobal_load_lds_dwordx4 %1, off\n\ts_mov_b32 m0, %0" : "=&s"(keep) : "v"(gsrc), "s"(lds_dst) : "memory"); }
__device__ __forceinline__ void glds16s(const void* sbase, unsigned voff, unsigned lds_dst) { unsigned keep;
    asm volatile("s_mov_b32 %0, m0\n\ts_mov_b32 m0, %3\n\ts_nop 0\n\tglobal_load_lds_dwordx4 %1, %2\n\ts_mov_b32 m0, %0" : "=&s"(keep) : "v"(voff), "s"(sbase), "s"(lds_dst) : "memory"); }
__device__ __forceinline__ void glds16s2(const void* sbase, unsigned voff, unsigned lds_dst) { unsigned keep;
    asm volatile("s_mov_b32 %0, m0\n\ts_mov_b32 m0, %3\n\ts_nop 0\n\tglobal_load_lds_dwordx4 %1, %2\n\tglobal_load_lds_dwordx4 %1, %2 offset:1024\n\ts_mov_b32 m0, %0" : "=&s"(keep) : "v"(voff), "s"(sbase), "s"(lds_dst) : "memory"); }
__device__ __forceinline__ float max3f(float a, float b, float c) { float r; asm("v_max3_f32 %0, %1, %2, %3" : "=v"(r) : "v"(a), "v"(b), "v"(c)); return r; }
typedef short v4i16_t __attribute__((ext_vector_type(4)));
__device__ __forceinline__ s16x4 vtr(const LAS unsigned char* p) { return __builtin_bit_cast(s16x4, __builtin_amdgcn_ds_read_tr16_b64_v4i16((LAS v4i16_t*)p)); }
#define ATT_WAIT_BAR(N) asm volatile("s_waitcnt vmcnt(" #N ") lgkmcnt(0)\n\ts_barrier" ::: "memory")

struct Args { const bf16_t* proj; unsigned char* out  ; const float* subw; const float* sinks; float lam, oscale; const unsigned* kmax; const bf16_t* kimg; const bf16_t* vimg; };
struct OrderTab { unsigned short v[2048]; unsigned short seg[9]; };
constexpr int est_cost(int u) { const int qt = u >> 4, h = u & 7; const int reach[8] = {5, 9, 15, 27, 52, 102, 202, 258};     const int c = 2 * qt + 2; return (c < reach[h] ? c : reach[h]) + 3; }
constexpr OrderTab make_order() { OrderTab t{};
    int gcost[64] = {}; for (int g = 0; g < 64; ++g) { const int bh = g >> 2, r = g & 3; for (int k = 0; k < 32; ++k) gcost[g] += est_cost((127 - 32 * r - k) * 16 + bh); }
    int ord[64] = {}; bool used[64] = {};
    for (int i = 0; i < 64; ++i) { int best = -1; for (int g = 0; g < 64; ++g) if (!used[g] && (best < 0 || gcost[g] > gcost[best])) best = g; used[best] = true; ord[i] = best; }
    int load[8] = {}; int own[64] = {};
    for (int i = 0; i < 64; ++i) { int x = 0; for (int j = 1; j < 8; ++j) if (load[j] < load[x]) x = j; own[ord[i]] = x; load[x] += gcost[ord[i]]; }
    int p = 0;
    for (int x = 0; x < 8; ++x) { t.seg[x] = (unsigned short)p;
        for (int i = 0; i < 64; ++i) { const int g = ord[i]; if (own[g] != x) continue; const int bh = g >> 2, r = g & 3;
            for (int k = 0; k < 32; ++k) t.v[p++] = (unsigned short)((127 - 32 * r - k) * 16 + bh); } }
    t.seg[8] = (unsigned short)p; return t; }
__device__ const OrderTab g_order = make_order();

template <bool SWA, bool FAST>
__device__ __forceinline__ void tile_loop(f32x16 (&o)[SWA ? 2 : 4], const bf16x8 (&qr)[4], float& mhat, float& lsum, int& NT, LAS unsigned char* lds, const LAS unsigned char* kp0, const LAS unsigned char* vp0,
                                          LAS float* wsf, const bf16_t* ksrc  , const bf16_t* vsrc, const unsigned koff  , const unsigned voff, const unsigned kdst, const unsigned vdst, const float cb, const float bnd,
                                          const int qt, const int q0, const int qrel, const int hi, const int r32, const int lane, const int wid, const int half) {
    constexpr int ND = SWA ? 2 : 4;
#define ATT_DMA(kt_, slot_) do { const size_t toff_ = (size_t)(kt_) * (SWA ? 64 * PITCH : 8192); const unsigned so_ = (unsigned)(slot_); \
        if (SWA) { glds16s(ksrc + toff_, koff, (unsigned)__builtin_amdgcn_readfirstlane(kdst + so_ * KSLOT)); \
                   glds16s(vsrc + toff_, voff, (unsigned)__builtin_amdgcn_readfirstlane(vdst + so_ * VSLOT)); } \
        else { glds16s2(ksrc + toff_, koff, (unsigned)__builtin_amdgcn_readfirstlane(kdst + so_ * KSLOT)); \
               glds16s2(vsrc + toff_, voff, (unsigned)__builtin_amdgcn_readfirstlane(vdst + so_ * VSLOT)); } } while (0)
#define ATT_KT(i_) ((i_) == 0 ? 2 * qt : ((i_) == 1 ? 2 * qt + 1 : 2 * qt + 1 - (i_)))
    ATT_DMA(ATT_KT(0), 0); ATT_DMA(ATT_KT(1), 1); if (NT > 2) ATT_DMA(ATT_KT(2), 2);
    if (SWA && NT > 3) ATT_DMA(ATT_KT(3), 3);
    int g = 0;
#define ATT_BARRIER() do { \
        if ((g & 1) == 0) { const int t_ = g >> 1; if (SWA) { if (t_ == 0) ATT_WAIT_BAR(0); }   \
            else if (t_ + 2 < NT) ATT_WAIT_BAR(8); else if (t_ + 1 < NT) ATT_WAIT_BAR(4); else ATT_WAIT_BAR(0); } \
        else { if (PINGPONG) asm volatile("s_waitcnt lgkmcnt(0)\n\ts_barrier" ::: "memory"); } \
        if (!SWA && g == 2) { \
            const LAS float* dq = (const LAS float*)(lds + LC_WSF) + 8 * 64; float dmax = dq[0]; \
            _Pragma("unroll") for (int w = 1; w < 8; ++w) dmax = fmaxf(dmax, dq[w]); \
            const float lim = ((float)(q0 - 63) - (dmax + 2.0f)) * (1.0f / 64.0f); \
            int kt_lo = (int)ceilf(lim); kt_lo = kt_lo < 0 ? 0 : kt_lo; kt_lo = __builtin_amdgcn_readfirstlane(kt_lo); \
            const int ntn = 2 * qt + 2 - kt_lo; NT = ntn < 2 ? 2 : (ntn < NT ? ntn : NT); } \
        if (!SWA && (g & 1)) { const int t2_ = (g >> 1) + 3; if (t2_ < NT) { const int s2_ = t2_ & 3; ATT_DMA(ATT_KT(t2_), s2_); } } \
        ++g; } while (0)
    if (PINGPONG && half == 1) ATT_BARRIER();
    float cstep[8];
#pragma unroll
    for (int m = 1; m < 8; ++m) cstep[m] = __builtin_bit_cast(float, __builtin_amdgcn_readfirstlane(__builtin_bit_cast(int, cb * (float)(8 * m))));
#define ATT_CINIT() do { float bs_[4]; bs_[0] = nb; bs_[1] = nb + cb; bs_[2] = fmaf(cb, 2.0f, nb); bs_[3] = fmaf(cb, 3.0f, nb); \
        _Pragma("unroll") for (int r = 0; r < 16; ++r) { const int m_ = r >> 2; float a_, b_; \
            if (m_ == 0) a_ = bs_[r & 3]; else asm("v_add_f32 %0, %1, %2" : "=v"(a_) : "s"(cstep[m_]), "v"(bs_[r & 3])); \
            asm("v_add_f32 %0, %1, %2" : "=v"(b_) : "s"(cstep[m_ + 4]), "v"(bs_[r & 3])); c0[r] = a_; c1[r] = b_; } } while (0)
    int slot = 0;
#pragma unroll 1
    for (int i = 0; i < NT; ++i) {
        ATT_BARRIER();
        if (SWA) { const bool lowq = (wid & 3) < 2; if (lowq ? (i == 1) : (i == 3)) { ATT_BARRIER(); slot = (slot + 1) & 3; continue; } }
        const int kt = ATT_KT(i); const int rel = 64 * (kt - 2 * qt);
        const LAS unsigned char* kp = kp0 + slot * KSLOT;
        const float nb = -mhat - cb * (float)(qrel - rel - 4 * hi);
        f32x16 c0, c1;
        if (FAST) {
            bf16x8 kf[8];
#pragma unroll
            for (int d0 = 0; d0 < 4; ++d0) { kf[2 * d0] = *(const LAS bf16x8*)(kp + d0 * 2048); kf[2 * d0 + 1] = *(const LAS bf16x8*)(kp + d0 * 2048 + 512); }
            ATT_CINIT();
            __builtin_amdgcn_sched_barrier(0);
#pragma unroll
            for (int d0 = 0; d0 < 4; ++d0) {
                c0 = __builtin_amdgcn_mfma_f32_32x32x16_bf16(kf[2 * d0], qr[d0], c0, 0, 0, 0);
                c1 = __builtin_amdgcn_mfma_f32_32x32x16_bf16(kf[2 * d0 + 1], qr[d0], c1, 0, 0, 0);
            }
            __builtin_amdgcn_sched_barrier(0);
        } else {
            ATT_CINIT();
#pragma unroll
            for (int d0 = 0; d0 < 4; ++d0) {
                const bf16x8 k0 = *(const LAS bf16x8*)(kp + d0 * 2048), k1 = *(const LAS bf16x8*)(kp + d0 * 2048 + 512);
                c0 = __builtin_amdgcn_mfma_f32_32x32x16_bf16(k0, qr[d0], c0, 0, 0, 0);
                c1 = __builtin_amdgcn_mfma_f32_32x32x16_bf16(k1, qr[d0], c1, 0, 0, 0);
            }
        }
        if (SWA ? (((wid & 3) < 2) ? (i != 2) : (i != 0)) : (i < 2)) {
            const int dd = qrel - rel - 4 * hi;
#pragma unroll
            for (int r = 0; r < 16; ++r) { const int d0_ = dd - ((r & 3) + 8 * (r >> 2)), d1_ = d0_ - 32;
                const bool v0 = SWA ? ((unsigned)d0_ < 128u) : (d0_ >= 0), v1 = SWA ? ((unsigned)d1_ < 128u) : (d1_ >= 0);
                c0[r] = v0 ? c0[r] : -INFINITY; c1[r] = v1 ? c1[r] : -INFINITY; }
        }
        float fsc = 1.0f;
        if (!FAST || i == 0) {
        float rm = max3f(c0[0], c1[0], c0[1]), rm2 = max3f(c1[1], c0[2], c1[2]);
#pragma unroll
        for (int r = 3; r < 15; r += 2) { rm = max3f(rm, c0[r], c1[r]); rm2 = max3f(rm2, c0[r + 1], c1[r + 1]); }
        rm = max3f(rm, c0[15], c1[15]); rm = max3f(rm, rm2, rm2);
        { auto rr = __builtin_amdgcn_permlane32_swap(__float_as_uint(rm), __float_as_uint(rm), false, false); rm = max3f(__uint_as_float(rr[0]), __uint_as_float(rr[1]), __uint_as_float(rr[1])); }
        if (i == 0) {
            mhat = rm;
#pragma unroll
            for (int r = 0; r < 16; ++r) { c0[r] -= rm; c1[r] -= rm; }
            if (!SWA) { float tq = (bnd - mhat + 128.0f) / cb;
#pragma unroll
                for (int o_ = 1; o_ < 32; o_ <<= 1) tq = fmaxf(tq, shx(tq, o_, lane));
                if (lane == 0) ((LAS float*)(lds + LC_WSF))[8 * 64 + wid] = tq; }
        } else if (!FAST) {
            const float dl = rm > 8.0f ? rm : 0.f; mhat += dl;
#pragma unroll
            for (int r = 0; r < 16; ++r) { c0[r] -= dl; c1[r] -= dl; }
            fsc = __builtin_amdgcn_exp2f(-dl); lsum *= fsc;
        }
        }
        if (!FAST) {
            if (hi == 0) wsf[r32] = fsc;
            asm volatile("s_waitcnt lgkmcnt(0)" ::: "memory");
#pragma unroll
            for (int r = 0; r < 16; ++r) { const float fr_ = wsf[crow(r, hi)];
#pragma unroll
                for (int d = 0; d < ND; ++d) { float t_ = o[d][r]; asm("v_mul_f32 %0, %1, %0" : "+v"(t_) : "v"(fr_)); o[d][r] = t_; } }
            asm volatile("s_waitcnt lgkmcnt(0)" ::: "memory");
        }
        float sacc = 0.f;
#pragma unroll
        for (int r = 0; r < 16; ++r) { c0[r] = __builtin_amdgcn_exp2f(c0[r]); c1[r] = __builtin_amdgcn_exp2f(c1[r]); sacc += c0[r] + c1[r]; }
        lsum += sacc;
        u32x4 pw[4];
#pragma unroll
        for (int j = 0; j < 4; ++j) { pw[0][j] = cvt_pk_bf16(c0[2 * j], c0[2 * j + 1]); pw[1][j] = cvt_pk_bf16(c0[8 + 2 * j], c0[9 + 2 * j]);
                                      pw[2][j] = cvt_pk_bf16(c1[2 * j], c1[2 * j + 1]); pw[3][j] = cvt_pk_bf16(c1[8 + 2 * j], c1[9 + 2 * j]); }
        ATT_BARRIER();
        const LAS unsigned char* vp = vp0 + slot * VSLOT;
        s16x4 vlo[2][4], vhi[2][4];
#define ATT_VLOAD(buf, d) do { _Pragma("unroll") for (int ks = 0; ks < 4; ++ks) { vlo[buf][ks] = vtr(vp + (d) * 4096 + ks * 1024); vhi[buf][ks] = vtr(vp + (d) * 4096 + ks * 1024 + 512); } } while (0)
#define ATT_VMMA(buf, d) do { _Pragma("unroll") for (int ks = 0; ks < 4; ++ks) { \
            const s16x4 lo_ = vlo[buf][ks], hh_ = vhi[buf][ks]; const bf16x8 vf_ = (bf16x8){lo_[0], lo_[1], lo_[2], lo_[3], hh_[0], hh_[1], hh_[2], hh_[3]}; \
            o[d] = __builtin_amdgcn_mfma_f32_32x32x16_bf16(__builtin_bit_cast(bf16x8, pw[ks]), vf_, o[d], 0, 0, 0); } } while (0)
        if (FAST) {
            ATT_VLOAD(0, 0); ATT_VLOAD(1, 1);
            __builtin_amdgcn_sched_barrier(0);
            ATT_VMMA(0, 0);
            __builtin_amdgcn_sched_barrier(0);
            ATT_VLOAD(0, 2); __builtin_amdgcn_sched_barrier(0);
            ATT_VMMA(1, 1);
            __builtin_amdgcn_sched_barrier(0);
            ATT_VLOAD(1, 3); __builtin_amdgcn_sched_barrier(0); ATT_VMMA(0, 2); __builtin_amdgcn_sched_barrier(0); ATT_VMMA(1, 3); __builtin_amdgcn_sched_barrier(0);
        } else {
#pragma unroll
            for (int d = 0; d < ND; ++d) { ATT_VLOAD(0, d); __builtin_amdgcn_sched_barrier(0); ATT_VMMA(0, d); __builtin_amdgcn_sched_barrier(0); }
        }
#undef ATT_VLOAD
#undef ATT_VMMA
        slot = (slot + 1) & 3;
    }
    if (PINGPONG && half == 0) ATT_BARRIER();
#undef ATT_BARRIER
#undef ATT_DMA
#undef ATT_KT
}
template <bool SWA>
__device__ __forceinline__ void attn_unit(const Args& A, int uid, LAS unsigned char* lds, const int wave_) {
    int l_; asm volatile("v_mbcnt_lo_u32_b32 %0, -1, 0\n\tv_mbcnt_hi_u32_b32 %0, -1, %0" : "=v"(l_));
    const int tid = wave_ * 64 + l_;
    constexpr int ND = SWA ? 2 : 4;
    constexpr int NDMA = SWA ? 2 : 4;
    const int lane = tid & 63, r32 = lane & 31, hi = lane >> 5;
    const int wid = __builtin_amdgcn_readfirstlane(tid >> 6), half = wid >> 2, quarter = wid & 3;
    int b, qt, hsel, kvh = 0, ocol0; float slope;
    if (!SWA) { const int bh = uid & 15; qt = uid >> 4; b = bh >> 3; hsel = bh & 7; slope = __builtin_amdgcn_exp2f(-(float)(hsel + 1)); ocol0 = hsel * 128; }
    else { b = uid & 1; kvh = (uid >> 1) & 1; const int j = (uid >> 2) & 3; qt = uid >> 4; hsel = kvh * 8 + 2 * j; slope = __builtin_amdgcn_exp2f(-0.5f * (float)(hsel + half + 1)); ocol0 = hsel * 64; }
    const float cb = slope * LOG2E;
    const size_t rowbase = (size_t)b * SEQ; const int q0 = qt * 128;
    const bf16_t* Qw = A.proj + (rowbase + q0 + quarter * 32) * PITCH + (SWA ? (COL_SQ + (hsel + half) * 64) : (COL_DQ + hsel * 128 + half * 64));
    const bf16_t* Kg = A.proj + rowbase * PITCH + (SWA ? (COL_SK + kvh * 64) : (COL_DK + hsel * 128));
    const bf16_t* Vg = A.proj + rowbase * PITCH + (SWA ? (COL_SV + kvh * 64) : (COL_DV + hsel * 128));
    const unsigned lds0 = (unsigned)(uintptr_t)lds;
    const bf16_t* ksrc = SWA ? Kg : A.kimg + (size_t)(b * 8 + hsel) * 256 * 8192;
    const bf16_t* vsrc = SWA ? Vg : A.vimg + (size_t)(b * 8 + hsel) * 256 * 8192;
    const unsigned koff = 2u * (unsigned)(SWA ? lane * PITCH + wid * 8 : wid * 1024 + lane * 8);
    const unsigned voff = 2u * (unsigned)(SWA ? (16 * (wid & 3) + (lane >> 2)) * PITCH + (wid >> 2) * 32 + (lane & 3) * 8 : wid * 1024 + lane * 8);
    const unsigned kdst = lds0 + LDS_K + wid * (SWA ? 1024 : 2048), vdst = lds0 + LDS_V + wid * (SWA ? 1024 : 2048);
    const LAS unsigned char* kp0 = lds + LDS_K + (SWA ? 0 : half * 8192) + hi * 1024 + r32 * 16;
    const LAS unsigned char* vp0 = lds + LDS_V + ((lane >> 4) & 1) * 32 + (lane & 3) * 8 + (4 * hi + ((lane & 15) >> 2)) * 64;
    LAS float* wsf = (LAS float*)(lds + LC_WSF) + wid * 64;
    bf16x8 qr[4];
#pragma unroll
    for (int d0 = 0; d0 < 4; ++d0) qr[d0] = *(const bf16x8*)(Qw + (size_t)r32 * PITCH + d0 * 16 + hi * 8);
    int NT = SWA ? (qt == 0 ? 2 : 4) : (2 * qt + 2);
    float bnd = 0.f;
    if (!SWA) { float qn = 0.f;
#pragma unroll
        for (int d0 = 0; d0 < 4; ++d0)
#pragma unroll
            for (int e = 0; e < 8; ++e) { const float qv = __uint_as_float(((unsigned)(unsigned short)qr[d0][e]) << 16); qn += qv * qv; }
        { auto rr = __builtin_amdgcn_permlane32_swap(__float_as_uint(qn), __float_as_uint(qn), false, false); qn = __uint_as_float(rr[0]) + __uint_as_float(rr[1]); }
        const unsigned* kmp = A.kmax + b * 32 + hsel * 4 + half * 2;
        const float k2 = __uint_as_float(__hip_atomic_load(kmp, RLX_AGENT)) + __uint_as_float(__hip_atomic_load(kmp + 1, RLX_AGENT));
        bnd = sqrtf(qn * k2) * 1.001f + 0.01f; }
    f32x16 o[ND];
#pragma unroll
    for (int d = 0; d < ND; ++d) o[d] = f32x16{};
    float mhat = 0.f, lsum = 0.f;
    const int qrel = quarter * 32 + r32;
    if (!SWA && !__any(bnd > 48.0f)) tile_loop<SWA, true>(o, qr, mhat, lsum, NT, lds, kp0, vp0, wsf, ksrc, vsrc, koff, voff, kdst, vdst, cb, bnd, qt, q0, qrel, hi, r32, lane, wid, half);
    else tile_loop<SWA, false>(o, qr, mhat, lsum, NT, lds, kp0, vp0, wsf, ksrc, vsrc, koff, voff, kdst, vdst, cb, bnd, qt, q0, qrel, hi, r32, lane, wid, half);
    int le_; asm volatile("v_mbcnt_lo_u32_b32 %0, -1, 0\n\tv_mbcnt_hi_u32_b32 %0, -1, %0" : "=v"(le_));
    const int tid_e = wave_ * 64 + le_, r32_e = le_ & 31, hi_e = le_ >> 5;
    LAS float* wsf_e = (LAS float*)(lds + LC_WSF) + wid * 64;
    { auto rr = __builtin_amdgcn_permlane32_swap(__float_as_uint(lsum), __float_as_uint(lsum), false, false); lsum = __uint_as_float(rr[0]) + __uint_as_float(rr[1]); }
    if (SWA) lsum += __builtin_amdgcn_exp2f(A.sinks[hsel + half] * LOG2E - mhat);
    if (hi_e == 0) wsf_e[32 + r32_e] = lsum;
    asm volatile("s_waitcnt lgkmcnt(0)" ::: "memory");
    float rli[16];
#pragma unroll
    for (int r = 0; r < 16; ++r) rli[r] = __builtin_amdgcn_rcpf(wsf_e[32 + crow(r, hi_e)]);
    ATT_WAIT_BAR(0);
    LAS float* ost = (LAS float*)(lds + LDS_K);
    if (!SWA) {
        if (half == 1) {
#pragma unroll
            for (int r = 0; r < 16; ++r)
#pragma unroll
                for (int d = 0; d < ND; ++d) ost[(quarter * 32 + crow(r, hi_e)) * OST + d * 32 + r32_e] = A.lam * o[d][r] * rli[r];
        }
        ATT_WAIT_BAR(0);
        if (half == 0) {
#pragma unroll
            for (int r = 0; r < 16; ++r)
#pragma unroll
                for (int d = 0; d < ND; ++d) { LAS float* p = ost + (quarter * 32 + crow(r, hi_e)) * OST + d * 32 + r32_e; *p = o[d][r] * rli[r] - *p; }
        }
        ATT_WAIT_BAR(0);
    } else {
#pragma unroll
        for (int r = 0; r < 16; ++r)
#pragma unroll
            for (int d = 0; d < ND; ++d) ost[(quarter * 32 + crow(r, hi_e)) * OST + half * 64 + d * 32 + r32_e] = o[d][r] * rli[r];
        ATT_WAIT_BAR(0);
    }
    {
        const int row = tid_e >> 2, cq = tid_e & 3; const LAS float* p = ost + row * OST + cq * 32; f32x4 v[8]; float ss = 0.f;
#pragma unroll
        for (int j = 0; j < 8; ++j) { v[j] = *(const LAS f32x4*)(p + 4 * j); ss += v[j][0] * v[j][0] + v[j][1] * v[j][1] + v[j][2] * v[j][2] + v[j][3] * v[j][3]; }
        float rs = 1.f;
        if (!SWA) { ss += dpp_xor1(ss); ss += dpp_xor2(ss); rs = A.oscale / sqrtf(ss * (1.0f / 128.0f) + RMS_EPS); }
        unsigned char* op = A.out + (rowbase + q0 + row) * DM + ocol0 + cq * 32;
        rs *= ATT_OSC;
#pragma unroll
        for (int j = 0; j < 8; j += 2) { f32x4 a = v[j] * rs, c = v[j + 1] * rs;
            if (!SWA) { const f32x4 w0 = *(const f32x4*)(A.subw + cq * 32 + 4 * j), w1 = *(const f32x4*)(A.subw + cq * 32 + 4 * j + 4); a = a * w0; c = c * w1; }
            u32x2 w; w.x = pk4_fp8(a[0], a[1], a[2], a[3]); w.y = pk4_fp8(c[0], c[1], c[2], c[3]);
            *(u32x2*)(op + 4 * j) = w; }
    }
    ATT_WAIT_BAR(0);
}
template <bool SWA, class BgF>
__device__ __forceinline__ void attn_phase(const Args& A, unsigned* qhead, int nunits, LAS unsigned char* lds, const int wave, const BgF& bgf, const int bid) {
    volatile LAS unsigned* bc = (volatile LAS unsigned*)(lds + LC_MISC) + 16;
    const int myx = SWA ? 0 : (int)((unsigned)__builtin_amdgcn_s_getreg((3 << 11) | 20) & 7u);
    int cnt = bid;
#pragma unroll 1
    for (int pass = 0; pass < (SWA ? 1 : 8); ++pass) {
        const int x = (myx + pass) & 7; const int s0 = SWA ? 0 : (int)g_order.seg[x], s1 = SWA ? nunits : (int)g_order.seg[x + 1];
        if (!SWA && pass >= 1) {
            if (pass == 1) { int l_; asm volatile("v_mbcnt_lo_u32_b32 %0, -1, 0\n\tv_mbcnt_hi_u32_b32 %0, -1, %0" : "=v"(l_));
                if (wave == 0 && l_ < 8) bc[4 + l_] = __hip_atomic_load(qhead + 64 * l_, RLX_AGENT);
                __syncthreads(); }
            if ((int)bc[4 + x] >= s1 - s0) continue;
        }
        for (;;) {
            const bool wantbg = (cnt % BgF::EVERY) == 0; ++cnt;
            { int l_; asm volatile("v_mbcnt_lo_u32_b32 %0, -1, 0\n\tv_mbcnt_hi_u32_b32 %0, -1, %0" : "=v"(l_));
              if (wave == 0 && l_ == 0) { const unsigned a_ = __hip_atomic_fetch_add(qhead + (SWA ? 0 : 64 * x), 1u, RLX_AGENT); unsigned b_ = (unsigned)BgF::TOTAL;
                  if (wantbg) b_ = __hip_atomic_fetch_add(bgf.ctr, 1u, RLX_AGENT); bc[0] = a_; bc[1] = b_; } }
            __syncthreads();
            const int u = s0 + (int)bc[0]; const int bi = (int)bc[1];
            __syncthreads();
            if (u >= s1) { if (bi < BgF::TOTAL) bgf(bi, lds, wave); break; }
            if (bi < BgF::TOTAL) bgf(bi, lds, wave);
            attn_unit<SWA>(A, SWA ? u : (int)g_order.v[u], lds, wave);
        }
    }
}
template <class BgF>
__device__ __forceinline__ void bg_drain(LAS unsigned char* lds, const int wave, const BgF& bgf) {
    volatile LAS unsigned* bc = (volatile LAS unsigned*)(lds + LC_MISC) + 16;
    for (;;) {
        { int l_; asm volatile("v_mbcnt_lo_u32_b32 %0, -1, 0\n\tv_mbcnt_hi_u32_b32 %0, -1, %0" : "=v"(l_));
          if (wave == 0 && l_ == 0) bc[1] = __hip_atomic_fetch_add(bgf.ctr, 1u, RLX_AGENT); }
        __syncthreads();
        const int bi = (int)bc[1];
        __syncthreads();
        if (bi >= BgF::TOTAL) break;
        bgf(bi, lds, wave);
    }
    __syncthreads();
}
}

#define XB_TMO      128
#define XB_XCNT(j)  (256  + 64 * (j))
#define XB_XSUB(j)  (1280 + 64 * (j))
#define XB_XGEN(j)  (2304 + 64 * (j))
#define XB_TOP      3328
#define XB_TOPGEN   3392
#define XCD_BAR_WORDS 3456
#define XB_SPIN_CAP (1u << 18)
__device__ __forceinline__ unsigned xb_ld(unsigned* p)              { return __hip_atomic_load(p, __ATOMIC_RELAXED, __HIP_MEMORY_SCOPE_AGENT); }
__device__ __forceinline__ unsigned xb_add(unsigned* p, unsigned v) { return __hip_atomic_fetch_add(p, v, __ATOMIC_RELAXED, __HIP_MEMORY_SCOPE_AGENT); }
__device__ __forceinline__ unsigned xb_xcc_id() { return (unsigned)__builtin_amdgcn_s_getreg((3 << 11) | 20) & 0xFu; }
#define XB_SPIN(cond, bar) do { unsigned _sp = 0; while (cond) { __builtin_amdgcn_s_sleep(1); \
    if ((++_sp & 255u) == 0u) { if (xb_ld(&(bar)[XB_TMO])) break; if (_sp > XB_SPIN_CAP) { atomicAdd(&(bar)[XB_TMO], 1u); break; } } } } while (0)
struct XcdBarrier { unsigned* bar; unsigned x; volatile LAS unsigned* st; };
__device__ __forceinline__ XcdBarrier xcd_barrier_post(unsigned* bar, volatile LAS unsigned* st) {
    XcdBarrier b; b.bar = bar; b.x = xb_xcc_id(); b.st = st;
    if (threadIdx.x == 0) (void)xb_add(&bar[XB_XCNT(b.x)], 1u);
    return b;
}
__device__ __forceinline__ void xcd_barrier_complete(unsigned* bar, unsigned x, unsigned& nloc, unsigned& nx) {
    const unsigned G = gridDim.x * gridDim.y * gridDim.z;
    unsigned sum, cnt, mine, sp = 0u;
    for (;;) {
        sum = 0u; cnt = 0u; mine = 0u;
#pragma unroll
        for (unsigned j = 0; j < 16; ++j) { const unsigned c = xb_ld(&bar[XB_XCNT(j)]); sum += c; cnt += (c > 0u) ? 1u : 0u; mine = (j == x) ? c : mine; }
        if (sum == G) break;
        __builtin_amdgcn_s_sleep(1);
        if ((++sp & 255u) == 0u) { if (xb_ld(&bar[XB_TMO])) break; if (sp > XB_SPIN_CAP) { atomicAdd(&bar[XB_TMO], 1u); break; } }
    }
    nloc = mine > 0u ? mine : 1u; nx = cnt > 0u ? cnt : 1u;
}
__device__ __forceinline__ void xcd_barrier(const XcdBarrier& b) {
    asm volatile("s_waitcnt vmcnt(0)" ::: "memory");
    __syncthreads();
    if (threadIdx.x == 0) {
        unsigned* bar = b.bar;
        __builtin_amdgcn_s_waitcnt(0);
        unsigned nloc = b.st[0], nx = b.st[1];
        if (nloc == 0u) { xcd_barrier_complete(bar, b.x, nloc, nx); b.st[0] = nloc; b.st[1] = nx; }
        const unsigned old = xb_add(&bar[XB_XSUB(b.x)], 1u);
        const unsigned gen = old / nloc;
        if (old + 1u == (gen + 1u) * nloc) {
            __builtin_amdgcn_fence(__ATOMIC_RELEASE, "agent");
            asm volatile("s_waitcnt vmcnt(0)" ::: "memory");
            const unsigned og = xb_add(&bar[XB_TOP], 1u);
            const unsigned tg = og / nx;
            if (og + 1u == (tg + 1u) * nx) xb_add(&bar[XB_TOPGEN], 1u);
            else XB_SPIN(xb_ld(&bar[XB_TOPGEN]) == tg, bar);
            __builtin_amdgcn_fence(__ATOMIC_ACQUIRE, "agent");
            xb_add(&bar[XB_XGEN(b.x)], 1u);
            asm volatile("s_waitcnt vmcnt(0)" ::: "memory");
        } else {
            XB_SPIN(xb_ld(&bar[XB_XGEN(b.x)]) == gen, bar);
            __builtin_amdgcn_fence(__ATOMIC_ACQUIRE, "agent");
            asm volatile("s_waitcnt vmcnt(0)" ::: "memory");
        }
    }
    __syncthreads();
}

constexpr int NWAVES = 8;
struct Frame { LAS unsigned char* lds; unsigned* ctl; int tid, lane, wave, G, bid; };

__device__ __forceinline__ unsigned f2bf(float f) { unsigned u = __builtin_bit_cast(unsigned, f); return (u + 0x7fffu + ((u >> 16) & 1u)) >> 16; }
__device__ __forceinline__ unsigned pk2(float lo, float hi) { return f2bf(lo) | (f2bf(hi) << 16); }

__device__ __forceinline__ void p0_transpose_item(const float* W, int K, int N, bf16_t* WT, LAS float* scr, int item, int lane, int ncols  ) {
    const int nblk = ncols / 32, kb = item / nblk, nb = item % nblk, k0 = 64 * kb, n0 = 32 * nb;
    float wv_[32];
#pragma unroll
    for (int i = 0; i < 32; ++i) wv_[i] = W[(size_t)(k0 + 2 * i + (lane >> 5)) * N + n0 + (lane & 31)];
#pragma unroll
    for (int i = 0; i < 32; ++i) scr[(2 * i + (lane >> 5)) * 33 + (lane & 31)] = wv_[i];
    LDS_WAIT(); asm volatile("" ::: "memory");
    const int c = lane & 7;
#pragma unroll
    for (int j = 0; j < 4; ++j) { const int n = (lane >> 3) + 8 * j; const LAS float* s = scr + (8 * c) * 33 + n;
        u32x4 o; o.x = pk2(s[0 * 33], s[1 * 33]); o.y = pk2(s[2 * 33], s[3 * 33]); o.z = pk2(s[4 * 33], s[5 * 33]); o.w = pk2(s[6 * 33], s[7 * 33]);
        *(u32x4*)(WT + (size_t)(n0 + n) * K + k0 + 8 * c) = o; }
    LDS_WAIT(); asm volatile("" ::: "memory");
}
__device__ __forceinline__ void bg_tile_load(float (&v)[64], const float* W, int N, int k0, int n0, int lane) {
    const float* src = W + (size_t)(k0 + 64 * (lane >> 5)) * N + n0 + (lane & 31);
#pragma unroll
    for (int i = 0; i < 64; ++i) v[i] = src[(size_t)i * N];
}
__device__ __forceinline__ void bg_tile_store(const float (&v)[64], unsigned char* WT, int K, int k0, int n0, int lane, float sc) {
    unsigned char* dst = WT + (size_t)(n0 + (lane & 31)) * K + k0 + 64 * (lane >> 5);
#pragma unroll
    for (int q = 0; q < 4; ++q) { u32x4 o;
        o.x = pk4_fp8(v[16 * q + 0] * sc, v[16 * q + 1] * sc, v[16 * q + 2] * sc, v[16 * q + 3] * sc);     o.y = pk4_fp8(v[16 * q + 4] * sc, v[16 * q + 5] * sc, v[16 * q + 6] * sc, v[16 * q + 7] * sc);
        o.z = pk4_fp8(v[16 * q + 8] * sc, v[16 * q + 9] * sc, v[16 * q + 10] * sc, v[16 * q + 11] * sc);   o.w = pk4_fp8(v[16 * q + 12] * sc, v[16 * q + 13] * sc, v[16 * q + 14] * sc, v[16 * q + 15] * sc);
        *(u32x4*)(dst + 16 * q) = o; }
}
__device__ __forceinline__ void p0_transpose_stack(const Frame& F, const float* W, bf16_t* WT, int nmat, int K, int N, LAS float* scr, int ncols = 0) {
    if (ncols == 0) ncols = N;
    const int per = (K / 64) * (ncols / 32), total = nmat * per; const int gw = F.bid * NWAVES + F.wave, NGW = F.G * NWAVES;
    for (int it = gw; it < total; it += NGW) { const int mi = it / per, r = it % per; p0_transpose_item(W + (size_t)mi * K * N, K, N, WT + (size_t)mi * K * N, scr, r, F.lane, ncols); }
}
__device__ __forceinline__ void cvt_rows_bf16(const Frame& F, const float* __restrict__ src, bf16_t* __restrict__ dst, size_t n  , unsigned char* __restrict__ dst8 = nullptr  ) {
    const size_t gt = (size_t)F.bid * (NWAVES * 64) + F.tid, NT = (size_t)F.G * NWAVES * 64;
    for (size_t i0 = gt * 8; i0 < n; i0 += NT * 8 * 4) { f32x4 a[4], b[4];
#pragma unroll
        for (int q = 0; q < 4; ++q) { const size_t i = i0 + (size_t)q * NT * 8; if (i < n) { a[q] = *(const f32x4*)(src + i); b[q] = *(const f32x4*)(src + i + 4); } }
#pragma unroll
        for (int q = 0; q < 4; ++q) { const size_t i = i0 + (size_t)q * NT * 8; if (i < n) {
            u32x4 w; w.x = cvt_pk_bf16(a[q][0], a[q][1]); w.y = cvt_pk_bf16(a[q][2], a[q][3]); w.z = cvt_pk_bf16(b[q][0], b[q][1]); w.w = cvt_pk_bf16(b[q][2], b[q][3]); *(u32x4*)(dst + i) = w;
            if (dst8) { u32x2 w8; w8.x = pk4_fp8(a[q][0] * XIN_SC, a[q][1] * XIN_SC, a[q][2] * XIN_SC, a[q][3] * XIN_SC); w8.y = pk4_fp8(b[q][0] * XIN_SC, b[q][1] * XIN_SC, b[q][2] * XIN_SC, b[q][3] * XIN_SC); *(u32x2*)(dst8 + i) = w8; } } } }
}

__device__ __forceinline__ void moe_tables(const Frame& F, const unsigned* gcnt  ) {
    LAS int* cnt = (LAS int*)(F.lds + LC_CNT); LAS int* offs = (LAS int*)(F.lds + LC_OFFS); LAS int* mts = (LAS int*)(F.lds + LC_MTS);
    __syncthreads();
    if (F.tid < NEXP) cnt[F.tid] = (int)__hip_atomic_load(gcnt + 64 * F.tid, RLX_AGENT);
    __syncthreads();
    if (F.tid == 0) { int o = 0; for (int e = 0; e < NEXP; ++e) { offs[e] = o; mts[e] = o >> 8; o += (cnt[e] + 255) & ~255; } offs[NEXP] = o; mts[NEXP] = o >> 8; }
    __syncthreads();
}

__device__ __forceinline__ void ln_row_stats(f32x4 (&v)[4], const f32x4 (&gg)[4], const f32x4 (&bb)[4], int lane, float& mean_o, float& rstd_o) {
    float s = 0.f;
#pragma unroll
    for (int j = 0; j < 4; ++j) s += (v[j][0] + v[j][1]) + (v[j][2] + v[j][3]);
    const float mean = wave_sum(s, lane) * (1.f / DM); float s2 = 0.f;
#pragma unroll
    for (int j = 0; j < 4; ++j) { v[j] = v[j] - mean; s2 += (v[j][0] * v[j][0] + v[j][1] * v[j][1]) + (v[j][2] * v[j][2] + v[j][3] * v[j][3]); }
    const float rstd = 1.f / sqrtf(wave_sum(s2, lane) * (1.f / DM) + LN_EPS);
#pragma unroll
    for (int j = 0; j < 4; ++j) v[j] = v[j] * rstd * gg[j] + bb[j];
    mean_o = mean; rstd_o = rstd;
}
__device__ __forceinline__ void ln_row_pre(f32x4 (&v)[4], const f32x4 (&gg)[4], const f32x4 (&bb)[4], int lane) {
    float s = 0.f;
#pragma unroll
    for (int j = 0; j < 4; ++j) s += (v[j][0] + v[j][1]) + (v[j][2] + v[j][3]);
    const float mean = wave_sum(s, lane) * (1.f / DM); float s2 = 0.f;
#pragma unroll
    for (int j = 0; j < 4; ++j) { v[j] = v[j] - mean; s2 += (v[j][0] * v[j][0] + v[j][1] * v[j][1]) + (v[j][2] * v[j][2] + v[j][3] * v[j][3]); }
    const float rstd = 1.f / sqrtf(wave_sum(s2, lane) * (1.f / DM) + LN_EPS);
#pragma unroll
    for (int j = 0; j < 4; ++j) v[j] = v[j] * rstd * gg[j] + bb[j];
}
__device__ __forceinline__ void ln_row(f32x4 (&v)[4], const float* g, const float* bta, int lane) {
    float s = 0.f;
#pragma unroll
    for (int j = 0; j < 4; ++j) s += (v[j][0] + v[j][1]) + (v[j][2] + v[j][3]);
    const float mean = wave_sum(s, lane) * (1.f / DM); float s2 = 0.f;
#pragma unroll
    for (int j = 0; j < 4; ++j) { v[j] = v[j] - mean; s2 += (v[j][0] * v[j][0] + v[j][1] * v[j][1]) + (v[j][2] * v[j][2] + v[j][3] * v[j][3]); }
    const float rstd = 1.f / sqrtf(wave_sum(s2, lane) * (1.f / DM) + LN_EPS);
#pragma unroll
    for (int j = 0; j < 4; ++j) { const f32x4 gg = *(const f32x4*)(g + 4 * lane + 256 * j), bb = *(const f32x4*)(bta + 4 * lane + 256 * j); v[j] = v[j] * rstd * gg + bb; }
}

__device__ __forceinline__ void phase_ln_router(const Frame& F, const bf16_t* pre, const float* g, const float* bta, bf16_t* x1b, unsigned char* x1f8,
                                                const float* wr  , const float* br, unsigned* gcnt, unsigned* ltok, float* lgate, int* toke, int* tokp) {
    LAS unsigned char* WH = F.lds + RING_OFF; LAS unsigned char* WL = WH + 65536;
    LAS int* lcnt = (LAS int*)(F.lds + LC_LCNT); LAS int* gbase = lcnt + 32;
    LAS float* lg = (LAS float*)(F.lds + LC_TOKC) + F.wave * (16 * 36);
    LAS int* ent_e = (LAS int*)(F.lds + LC_ENT); LAS int* ent_p = ent_e + 512; LAS float* ent_g = (LAS float*)(ent_p + 512);
    LAS float* part = (LAS float*)(F.lds + LC_ENT);
    LAS float* sE = (LAS float*)(F.lds + LC_LOG); LAS float* cE = sE + 32;
    LAS float* stats = (LAS float*)(F.lds + LC_WSF) + F.wave * 32;
    __syncthreads();
    float sp = 0.f, cp = 0.f;
#pragma unroll 1
    for (int it = 0; it < (DM * NEXP) / (NWAVES * 64 * 16); ++it) { float wv[16], gv[16], bv[16];
#pragma unroll
        for (int j = 0; j < 16; ++j) { const int idx = F.tid + (it * 16 + j) * (NWAVES * 64); wv[j] = wr[idx]; gv[j] = g[idx >> 5]; bv[j] = bta[idx >> 5]; }
#pragma unroll
        for (int j = 0; j < 16; ++j) { const int idx = F.tid + (it * 16 + j) * (NWAVES * 64); const int d = idx >> 5, e = idx & 31; const float w = wv[j] * gv[j];
            const unsigned hb = cvt_pk_bf16(w, 0.f) & 0xffffu; const float wl = w - __uint_as_float(hb << 16); const unsigned lb = cvt_pk_bf16(wl, 0.f) & 0xffffu;
            sp += __uint_as_float(hb << 16) + __uint_as_float(lb << 16); cp += bv[j] * wv[j];
            const int off = e * 2048 + ((((d >> 3) ^ (e & 7))) << 4) + (d & 7) * 2;
            *(LAS unsigned short*)(WH + off) = (unsigned short)hb; *(LAS unsigned short*)(WL + off) = (unsigned short)lb; } }
    part[(F.tid >> 5) * 32 + (F.tid & 31)] = sp; part[512 + (F.tid >> 5) * 32 + (F.tid & 31)] = cp;
    __syncthreads();
    if (F.tid < 32) { float a = 0.f, c = 0.f;
#pragma unroll
        for (int i = 0; i < 16; ++i) { a += part[i * 32 + F.tid]; c += part[512 + i * 32 + F.tid]; }
        sE[F.tid] = a; cE[F.tid] = c + br[F.tid]; }
    __syncthreads();
    const int lane = F.lane;
    const int mrow = lane & 15, kq = lane >> 4;
    for (int chunk = F.bid; chunk < NTOK / 128; chunk += F.G) {
        __syncthreads();
        if (F.tid < 32) lcnt[F.tid] = 0;
        __syncthreads();
        const size_t row0 = (size_t)chunk * 128 + F.wave * 16;
        f32x4 gg[4], bb[4];
#pragma unroll
        for (int j = 0; j < 4; ++j) { gg[j] = *(const f32x4*)(g + 4 * lane + 256 * j); bb[j] = *(const f32x4*)(bta + 4 * lane + 256 * j); }
#pragma unroll 1
        for (int rb = 0; rb < 16; rb += 8) {
            u32x2 raw[8][4];
#pragma unroll
            for (int r = 0; r < 8; ++r)
#pragma unroll
                for (int j = 0; j < 4; ++j) raw[r][j] = *(const u32x2*)(pre + (row0 + rb + r) * DM + 4 * lane + 256 * j);
#pragma unroll
            for (int r = 0; r < 8; ++r) { const size_t row = row0 + rb + r;
                f32x4 v[4];
#pragma unroll
                for (int j = 0; j < 4; ++j) v[j] = (f32x4){bf_lo(raw[r][j].x), bf_hi(raw[r][j].x), bf_lo(raw[r][j].y), bf_hi(raw[r][j].y)};
                float mean_, rstd_;
                ln_row_stats(v, gg, bb, lane, mean_, rstd_);
                if (lane == 0) { stats[2 * (rb + r)] = mean_; stats[2 * (rb + r) + 1] = rstd_; }
#pragma unroll
                for (int j = 0; j < 4; ++j) {
                    u32x2 w; w.x = cvt_pk_bf16(v[j][0], v[j][1]); w.y = cvt_pk_bf16(v[j][2], v[j][3]); *(u32x2*)(x1b + row * DM + 4 * lane + 256 * j) = w;
                    *(unsigned*)(x1f8 + row * DM + 4 * lane + 256 * j) = pk4_fp8(v[j][0] * 4.0f, v[j][1] * 4.0f, v[j][2] * 4.0f, v[j][3] * 4.0f); }
            }
        }
        f32x4 lacc[2] = {(f32x4){0.f, 0.f, 0.f, 0.f}, (f32x4){0.f, 0.f, 0.f, 0.f}};
        const bf16_t* xp = pre + (row0 + mrow) * DM + kq * 8;
#pragma unroll 8
        for (int ks = 0; ks < 32; ++ks) {
            const bf16x8 ah = *(const bf16x8*)(xp + ks * 32);
#pragma unroll
            for (int nb = 0; nb < 2; ++nb) { const int e = nb * 16 + mrow; const int off = e * 2048 + (((ks * 4 + kq) ^ (e & 7)) << 4);
                const bf16x8 bh = *(const LAS bf16x8*)(WH + off), bl = *(const LAS bf16x8*)(WL + off);
                lacc[nb] = __builtin_amdgcn_mfma_f32_16x16x32_bf16(ah, bh, lacc[nb], 0, 0, 0);
                lacc[nb] = __builtin_amdgcn_mfma_f32_16x16x32_bf16(ah, bl, lacc[nb], 0, 0, 0); }
        }
        LDS_WAIT(); asm volatile("" ::: "memory");
#pragma unroll
        for (int nb = 0; nb < 2; ++nb) { const float se_ = sE[nb * 16 + mrow], ce_ = cE[nb * 16 + mrow];
#pragma unroll
            for (int r = 0; r < 4; ++r) { const float mean_ = stats[2 * (4 * kq + r)], rstd_ = stats[2 * (4 * kq + r) + 1];
                lg[(4 * kq + r) * 36 + nb * 16 + mrow] = rstd_ * (lacc[nb][r] - mean_ * se_) + ce_; } }
        LDS_WAIT(); asm volatile("" ::: "memory");
        if (lane < 16) {
            const int rl = F.wave * 16 + lane;
            float lv[32];
#pragma unroll
            for (int c = 0; c < 8; ++c) { const f32x4 t = *(const LAS f32x4*)(lg + lane * 36 + 4 * c); lv[4 * c] = t[0]; lv[4 * c + 1] = t[1]; lv[4 * c + 2] = t[2]; lv[4 * c + 3] = t[3]; }
            float tv[4]; int ti[4];
#pragma unroll
            for (int k = 0; k < 4; ++k) { float best = -INFINITY; int bi = 0;
#pragma unroll
                for (int e = 0; e < 32; ++e) { const bool gt = lv[e] > best; best = gt ? lv[e] : best; bi = gt ? e : bi; }
                tv[k] = best; ti[k] = bi;
#pragma unroll
                for (int e = 0; e < 32; ++e) lv[e] = (e == bi) ? -INFINITY : lv[e]; }
            const float e1 = __expf(tv[1] - tv[0]), e2 = __expf(tv[2] - tv[0]), e3 = __expf(tv[3] - tv[0]); const float inv = 1.0f / (1.0f + e1 + e2 + e3);
            const float gk[4] = {inv, e1 * inv, e2 * inv, e3 * inv};
#pragma unroll
            for (int k = 0; k < 4; ++k) { const int lp = atomicAdd((int*)(lcnt + ti[k]), 1); ent_e[rl * 4 + k] = ti[k]; ent_p[rl * 4 + k] = lp; ent_g[rl * 4 + k] = gk[k]; }
        }
        __syncthreads();
        if (F.tid < 32) gbase[F.tid] = (int)__hip_atomic_fetch_add(gcnt + 64 * F.tid, (unsigned)lcnt[F.tid], RLX_AGENT);
        __syncthreads();
        { const int idx = F.tid; const int e = ent_e[idx], pos = gbase[e] + ent_p[idx]; const int tk = chunk * 512 + idx;
            ltok[(size_t)e * LIST_CAP + pos] = (unsigned)tk; lgate[(size_t)e * LIST_CAP + pos] = ent_g[idx]; toke[tk] = e; tokp[tk] = pos; }
    }
    __syncthreads();
}

__device__ __forceinline__ void phase_combine_ln(const Frame& F, const bf16_t* __restrict__ pre, const unsigned char* __restrict__ Y, const int* __restrict__ toke, const int* __restrict__ tokp,
                                                 const float* __restrict__ g, const float* __restrict__ bta, float* __restrict__ xo, bf16_t* __restrict__ xob, unsigned char* __restrict__ xob8) {
    const LAS int* offs = (const LAS int*)(F.lds + LC_OFFS);
    const int gw = F.bid * NWAVES + F.wave, NGW = F.G * NWAVES, lane = F.lane;
    f32x4 gg[4], bb[4];
#pragma unroll
    for (int j = 0; j < 4; ++j) { gg[j] = *(const f32x4*)(g + 16 * lane + 4 * j); bb[j] = *(const f32x4*)(bta + 16 * lane + 4 * j); }
    i32x4 te[2], tp[2];
#pragma unroll
    for (int q = 0; q < 2; ++q) { const int r = (gw + q * NGW < NTOK) ? gw + q * NGW : (gw < NTOK ? gw : 0); te[q] = *(const i32x4*)(toke + (size_t)r * 4); tp[q] = *(const i32x4*)(tokp + (size_t)r * 4); }
    for (int row0 = gw; row0 < NTOK; row0 += 2 * NGW) {
        const int rows[2] = {row0, row0 + NGW}; const bool ok1 = rows[1] < NTOK;
        u32x4 pv[2][2], yv[2][4];
#pragma unroll
        for (int q = 0; q < 2; ++q) { const int r = (q == 0 || ok1) ? rows[q] : rows[0];
            pv[q][0] = *(const u32x4*)(pre + (size_t)r * DM + 16 * lane); pv[q][1] = *(const u32x4*)(pre + (size_t)r * DM + 16 * lane + 8);
#pragma unroll
            for (int k = 0; k < 4; ++k) { const size_t slot = (size_t)(offs[te[q][k]] + tp[q][k]); yv[q][k] = *(const u32x4*)(Y + slot * DM + 16 * lane); } }
#pragma unroll
        for (int q = 0; q < 2; ++q) { const int rn = row0 + 2 * NGW + q * NGW; const int r = rn < NTOK ? rn : row0; te[q] = *(const i32x4*)(toke + (size_t)r * 4); tp[q] = *(const i32x4*)(tokp + (size_t)r * 4); }
#pragma unroll
        for (int q = 0; q < 2; ++q) { if (q == 1 && !ok1) break; const int row = rows[q];
            f32x4 v[4];
#pragma unroll
            for (int j = 0; j < 4; ++j) { const unsigned p0 = pv[q][j >> 1][(j & 1) * 2], p1 = pv[q][j >> 1][(j & 1) * 2 + 1];
                f32x4 ys = (f32x4){0.f, 0.f, 0.f, 0.f};
#pragma unroll
                for (int k = 0; k < 4; ++k) { const int yw = (int)yv[q][k][j]; const auto lo = __builtin_amdgcn_cvt_pk_f32_fp8(yw, false), hi = __builtin_amdgcn_cvt_pk_f32_fp8(yw, true);
                    ys[0] += lo[0]; ys[1] += lo[1]; ys[2] += hi[0]; ys[3] += hi[1]; }
                v[j] = (f32x4){bf_lo(p0), bf_hi(p0), bf_lo(p1), bf_hi(p1)} + ys * (1.0f / moe::YSC); }
            ln_row_pre(v, gg, bb, lane);
#pragma unroll
            for (int j = 0; j < 4; ++j) if (xo) *(f32x4*)(xo + (size_t)row * DM + 16 * lane + 4 * j) = v[j];
            if (!xo) {
#pragma unroll
                for (int h = 0; h < 2; ++h) { u32x4 w; w.x = cvt_pk_bf16(v[2 * h][0], v[2 * h][1]); w.y = cvt_pk_bf16(v[2 * h][2], v[2 * h][3]); w.z = cvt_pk_bf16(v[2 * h + 1][0], v[2 * h + 1][1]); w.w = cvt_pk_bf16(v[2 * h + 1][2], v[2 * h + 1][3]);
                    *(u32x4*)(xob + (size_t)row * DM + 16 * lane + 8 * h) = w; }
                u32x4 w8;
#pragma unroll
                for (int j = 0; j < 4; ++j) w8[j] = pk4_fp8(v[j][0] * XIN_SC, v[j][1] * XIN_SC, v[j][2] * XIN_SC, v[j][3] * XIN_SC);
                *(u32x4*)(xob8 + (size_t)row * DM + 16 * lane) = w8; } }
    }
}

struct KArgs { const float* in[26]; float* out; unsigned char* ws; int ph_lo, ph_hi; };
typedef const __attribute__((address_space(4))) KArgs* KAP;
#define KA() ({ KAP p_ = (KAP)__builtin_amdgcn_kernarg_segment_ptr(); asm volatile("" : "+s"(p_)); p_; })
#define KIN(k) ((const float*)ka->in[k])
#define WSP(T, off) ((T*)(ka->ws + (off)))

struct BgStage {
    static constexpr int BG_T = 4, EVERY = 4;
    static constexpr int T_GU = NEXP * (DM / 128) * (2 * DM / 32), T_DN = NEXP * (DM / 128) * (DM / 32), T_PG = (DM / 128) * (DM / 32), T_AB = 2 * T_PG, TOTAL = (T_GU + T_DN + T_PG + T_AB) / (8 * BG_T);
    static_assert(T_GU % (8 * BG_T) == 0 && T_DN % (8 * BG_T) == 0 && T_PG % (8 * BG_T) == 0 && T_AB % (8 * BG_T) == 0 && BG_T % 2 == 0, "block-items do not straddle the two weight stacks");
    unsigned* ctr; int layer;
    struct Tile { const float* W; unsigned char* WT; int N, k0, n0; float sc; };
    __device__ __forceinline__ Tile tile(KAP ka, int t) const { Tile r;
        if (t < T_GU) { const int mi = layer * NEXP + (t >> 9), q = t & 511; r.W = KIN(18) + (size_t)mi * DM * 2 * DM; r.WT = WSP(unsigned char, WS_WGU) + (size_t)mi * DM * 2 * DM; r.N = 2 * DM; r.k0 = (q >> 6) * 128; r.n0 = (q & 63) * 32; r.sc = moe::WGUSC; }
        else if (t >= T_GU + T_DN + T_PG) { const int t3 = t - T_GU - T_DN - T_PG, w_ = t3 >> 8, q = t3 & 255;
            r.W = KIN(10 + w_) + (size_t)layer * DM * DM; r.WT = WSP(unsigned char, w_ ? WS_WB : WS_WA) + (size_t)layer * DM * DM; r.N = DM; r.k0 = (q >> 5) * 128; r.n0 = (q & 31) * 32; r.sc = WAB_SC; }
        else if (t >= T_GU + T_DN) { const int q = t - T_GU - T_DN; r.W = KIN(22) + (size_t)layer * DM * DM; r.WT = WSP(unsigned char, WS_WPG8) + (size_t)layer * DM * DM; r.N = DM; r.k0 = (q >> 5) * 128; r.n0 = (q & 31) * 32; r.sc = WPGSC; }
        else { const int t2 = t - T_GU, mi = layer * NEXP + (t2 >> 8), q = t2 & 255; r.W = KIN(20) + (size_t)mi * DM * DM; r.WT = WSP(unsigned char, WS_WDN) + (size_t)mi * DM * DM; r.N = DM; r.k0 = (q >> 5) * 128; r.n0 = (q & 31) * 32; r.sc = moe::WDNSC; }
        return r; }
    __device__ __forceinline__ void operator()(int bi, LAS unsigned char*, int wave) const {
        int l_; asm volatile("v_mbcnt_lo_u32_b32 %0, -1, 0\n\tv_mbcnt_hi_u32_b32 %0, -1, %0" : "=v"(l_));
        KAP ka = KA();
        const int t0 = bi * (8 * BG_T) + wave;
        float va[64], vb[64];
        Tile ta = tile(ka, t0), tb;
        bg_tile_load(va, ta.W, ta.N, ta.k0, ta.n0, l_);
#pragma unroll
        for (int s_ = 1; s_ < BG_T; s_ += 2) {
            tb = tile(ka, t0 + 8 * s_);
            bg_tile_load(vb, tb.W, tb.N, tb.k0, tb.n0, l_);
            bg_tile_store(va, ta.WT, DM, ta.k0, ta.n0, l_, ta.sc);
            if (s_ + 1 < BG_T) { ta = tile(ka, t0 + 8 * (s_ + 1)); bg_tile_load(va, ta.W, ta.N, ta.k0, ta.n0, l_); }
            bg_tile_store(vb, tb.WT, DM, tb.k0, tb.n0, l_, tb.sc);
        }
    }
};

constexpr int NPH_LAYER = 9, NPHASES = 1 + DEPTH * NPH_LAYER;
__global__ void __launch_bounds__(NWAVES * 64, 2) mk_fwd(KArgs args) {
    extern __shared__ __attribute__((aligned(16))) unsigned char lds_raw[];
    Frame F; F.lds = (LAS unsigned char*)lds_raw; F.tid = threadIdx.x; F.lane = F.tid & 63; F.wave = __builtin_amdgcn_readfirstlane(F.tid >> 6); F.G = gridDim.x; F.bid = blockIdx.x;
    const int wave0 = F.wave;
#define REFRAME() do { int l_; asm volatile("v_mbcnt_lo_u32_b32 %0, -1, 0\n\tv_mbcnt_hi_u32_b32 %0, -1, %0" : "=v"(l_)); int w_ = wave0; asm volatile("" : "+s"(w_)); \
        F.lane = l_; F.wave = w_; F.tid = w_ * 64 + l_; int b_ = blockIdx.x; asm volatile("" : "+s"(b_)); F.bid = b_; } while (0)
    F.ctl = (unsigned*)(args.ws + WS_CTL);
    volatile LAS unsigned* MISC = (volatile LAS unsigned*)(F.lds + LC_MISC);
    if (F.tid < 64) MISC[F.tid] = 0u;
    __syncthreads();
    XcdBarrier bar; bar.bar = F.ctl + CW_BAR; bar.x = 0; bar.st = nullptr;
    if (MK_N_LAUNCHES == 1) bar = xcd_barrier_post(F.ctl + CW_BAR, MISC + 8);
    const int lo = args.ph_lo, hi = args.ph_hi;
#ifndef PH_MASK
#define PH_MASK 0x3ff
#endif
#define PON(id) (((PH_MASK) >> (id)) & 1)
#define IN(k) (lo <= (k) && (k) < hi)
#define SEAM(k) do { if (IN(k) && IN((k) + 1)) xcd_barrier(bar); } while (0)
#ifdef DOUBLE_PHASE
#define NREP(k) (((k) == DOUBLE_PHASE) ? 2 : 1)
#else
#define NREP(k) 1
#endif
#define PHASE_LOOP(k) for (int rep = 0; rep < NREP(k); ++rep)
#define PHASE_REDO(k) do { if (rep + 1 < NREP(k)) xcd_barrier(bar); } while (0)
    if (PON(0) && IN(0)) PHASE_LOOP(0) { REFRAME();
        LAS float* scr = (LAS float*)(F.lds + RING_OFF + F.wave * 16384);
        { KAP ka = KA(); p0_transpose_stack(F, KIN(2), WSP(bf16_t, WS_WIN), DEPTH, DM, INW, scr, NT_PROJ * 256); }
        { KAP ka = KA(); p0_transpose_stack(F, KIN(12), WSP(bf16_t, WS_WOUT), DEPTH, DM, DM, scr); }
        { KAP ka = KA(); p0_transpose_stack(F, KIN(23), WSP(bf16_t, WS_WPP), DEPTH, PLED, DM, scr); }
        { KAP ka = KA(); cvt_rows_bf16(F, KIN(0), WSP(bf16_t, WS_XB), (size_t)NTOK * DM, WSP(unsigned char, WS_XB8)); }
        { KAP ka = KA();
          for (int t = F.bid * NWAVES + F.wave; t < DEPTH * 512; t += F.G * NWAVES) { const int ly = t >> 9, q = t & 511, k0 = (q >> 6) * 128, n0 = (q & 63) * 32;
              float vt[64]; bg_tile_load(vt, KIN(2) + (size_t)ly * DM * INW + NT_PROJ * 256, INW, k0, n0, F.lane);
              bg_tile_store(vt, WSP(unsigned char, WS_WIN8) + (size_t)ly * 2048 * DM, DM, k0, n0, F.lane, WING_SC); } }
        { KAP ka = KA(); cvt_rows_bf16(F, KIN(1), WSP(bf16_t, WS_PB), (size_t)DEPTH * NTOK * PLED); }
        VM_WAIT(); __syncthreads(); PHASE_REDO(0);
    }
    SEAM(0);

#pragma unroll 1
    for (int layer = 0; layer < DEPTH; ++layer) {
        const int pb = 1 + layer * NPH_LAYER;
        unsigned* gcnt = F.ctl + CW_CNT + layer * NEXP * 64;
        if (PON(1) && IN(pb + 0)) PHASE_LOOP(pb + 0) { REFRAME();
            { KAP ka = KA(); pg8::DenseSched S; S.init(WSP(bf16_t, WS_XB), WSP(bf16_t, WS_WIN) + (size_t)layer * INW * DM, NTOK, NT_PROJ * 256, DM, F.G, F.bid);
              pg8::EpiProj E{WSP(bf16_t, WS_PROJ), INW, KIN(3) + (size_t)layer * INW, true, F.ctl + CW_KMAX + layer * 64, WSP(bf16_t, WS_KIMG), WSP(bf16_t, WS_VIMG), 0};
              pg8::gemm_phase<pg8::EpiProj, pg8::DenseSched>(F.lds + RING_OFF, DM, S, E, F.tid); }
            REFRAME();
            { KAP ka = KA(); pg8::DenseSchedF8in S; S.init(WSP(unsigned char, WS_XB8), WSP(unsigned char, WS_WIN8) + (size_t)layer * 2048 * DM, NTOK, NT_GATE * 256, DM / 2, F.G, F.bid);
              { constexpr int NU = (NTOK / 256) * NT_PROJ, NF = (NTOK / 256) * NT_GATE; const int rem = NU % F.G, num = NF - 2 * (F.G - rem);
                if (rem != 0 && num >= 0 && num % F.G == 0 && (rem % 8) == 0) { S.nl = rem; S.cntL = num / F.G; S.cntS = S.cntL + 2; } }
              pg8::EpiProj E{WSP(bf16_t, WS_PROJ), INW, KIN(3) + (size_t)layer * INW, false, nullptr, nullptr, nullptr, NT_PROJ};
              pg8::gemm_phase<pg8::EpiProj, pg8::DenseSchedF8in, true, true>(F.lds + RING_OFF, DM / 2, S, E, F.tid); }
            REFRAME();
            { KAP ka = KA(); pg8::DenseSched S; S.init(WSP(bf16_t, WS_PB) + (size_t)layer * NTOK * PLED, WSP(bf16_t, WS_WPP) + (size_t)layer * DM * PLED, NTOK, DM, PLED, F.G, F.bid);
              pg8::EpiProj E{WSP(bf16_t, WS_TPP), DM, nullptr, false, nullptr, nullptr, nullptr, 0};
              pg8::gemm_phase<pg8::EpiProj, pg8::DenseSched>(F.lds + RING_OFF, PLED, S, E, F.tid); }
        PHASE_REDO(pb + 0); }
        SEAM(pb + 0);
        if (PON(2) && IN(pb + 1)) PHASE_LOOP(pb + 1) { REFRAME();
            const float lam_init = layer == 0 ? 0.2f : 0.35550906759096926f;
            { KAP ka = KA();
              float d1 = KIN(4)[layer * 64 + F.lane] * KIN(5)[layer * 64 + F.lane], d2 = KIN(6)[layer * 64 + F.lane] * KIN(7)[layer * 64 + F.lane];
              d1 = wave_sum(d1, F.lane); d2 = wave_sum(d2, F.lane);
              float lam, osc;
              { const float lv_ = __expf(d1) - __expf(d2) + lam_init, ov_ = 1.0f - lam_init; unsigned ls_, os_;
                asm volatile("s_nop 7\n\tv_readfirstlane_b32 %0, %2\n\tv_readfirstlane_b32 %1, %3\n\ts_nop 7" : "=&s"(ls_), "=&s"(os_) : "v"(lv_), "v"(ov_)); lam = __uint_as_float(ls_); osc = __uint_as_float(os_); }
              att::Args A{WSP(bf16_t, WS_PROJ), WSP(unsigned char, WS_OD), KIN(8) + layer * 128, KIN(9) + layer * 16, lam, osc, F.ctl + CW_KMAX + layer * 64, WSP(bf16_t, WS_KIMG), WSP(bf16_t, WS_VIMG)};
              att::attn_phase<false>(A, F.ctl + CW_QX + (layer * 2 + rep) * 512, NBATCH * 8 * (SEQ / 128), F.lds, F.wave, BgStage{F.ctl + CW_BG + layer * 64, layer}, F.bid); }
            REFRAME();
            { KAP ka = KA();
              att::Args B{WSP(bf16_t, WS_PROJ), WSP(unsigned char, WS_OS), KIN(8) + layer * 128, KIN(9) + layer * 16, 0.f, 1.0f, F.ctl + CW_KMAX + layer * 64, nullptr, nullptr};
              att::attn_phase<true>(B, F.ctl + CW_Q + (layer * 2 + 1) * 64 + rep * 16, NBATCH * 2 * 4 * (SEQ / 128), F.lds, F.wave, BgStage{F.ctl + CW_BG + layer * 64, layer}, F.bid);
              att::bg_drain(F.lds, F.wave, BgStage{F.ctl + CW_BG + layer * 64, layer}); }
        PHASE_REDO(pb + 1); }
        SEAM(pb + 1);
        if (PON(3) && IN(pb + 2)) PHASE_LOOP(pb + 2) { REFRAME();
            { KAP ka = KA(); pg8::DenseSchedF8in S; S.init(WSP(unsigned char, WS_OD), WSP(unsigned char, WS_WA) + (size_t)layer * DM * DM, NTOK, DM, DM / 2, F.G, F.bid);
              pg8::EpiGate<false> E{WSP(bf16_t, WS_MG), WSP(bf16_t, WS_PROJ), COL_GA};
              pg8::gemm_phase<pg8::EpiGate<false>, pg8::DenseSchedF8in, true, true>(F.lds + RING_OFF, DM / 2, S, E, F.tid); }
            VM_WAIT(); REFRAME();
            { KAP ka = KA(); pg8::DenseSchedF8in S; S.init(WSP(unsigned char, WS_OS), WSP(unsigned char, WS_WB) + (size_t)layer * DM * DM, NTOK, DM, DM / 2, F.G, F.bid);
              pg8::EpiGate<true> E{WSP(bf16_t, WS_MG), WSP(bf16_t, WS_PROJ), COL_GB};
              pg8::gemm_phase<pg8::EpiGate<true>, pg8::DenseSchedF8in, true, true>(F.lds + RING_OFF, DM / 2, S, E, F.tid); }
        PHASE_REDO(pb + 2); }
        SEAM(pb + 2);
        if (PON(4) && IN(pb + 3)) PHASE_LOOP(pb + 3) { REFRAME();
            KAP ka = KA(); pg8::DenseSched S; S.init(WSP(bf16_t, WS_MG), WSP(bf16_t, WS_WOUT) + (size_t)layer * DM * DM, NTOK, DM, DM, F.G, F.bid);
            pg8::EpiRes E{KIN(0), (layer == 0) ? (const bf16_t*)nullptr : (const bf16_t*)WSP(bf16_t, WS_XB), WSP(bf16_t, WS_PRE), KIN(13) + layer * DM};
            pg8::gemm_phase<pg8::EpiRes, pg8::DenseSched>(F.lds + RING_OFF, DM, S, E, F.tid);
        PHASE_REDO(pb + 3); }
        SEAM(pb + 3);
        if (PON(5) && IN(pb + 4)) PHASE_LOOP(pb + 4) { REFRAME();
            KAP ka = KA();
            const bool dummy = rep + 1 < NREP(pb + 4);
            phase_ln_router(F, WSP(bf16_t, WS_PRE), KIN(14) + layer * DM, KIN(15) + layer * DM, WSP(bf16_t, WS_X1B), WSP(unsigned char, WS_X1F8), KIN(16) + (size_t)layer * DM * NEXP, KIN(17) + layer * NEXP, dummy ? F.ctl + 65536 : gcnt,
                            WSP(unsigned, dummy ? WS_Y : WS_LTOK), WSP(float, dummy ? WS_Y + 8 * MiB : WS_LGATE), WSP(int, dummy ? WS_Y + 16 * MiB : WS_TOKE), WSP(int, dummy ? WS_Y + 24 * MiB : WS_TOKP));
        PHASE_REDO(pb + 4); }
        SEAM(pb + 4);
        if (PON(6) && IN(pb + 5)) PHASE_LOOP(pb + 5) { REFRAME();
            moe_tables(F, gcnt);
            KAP ka = KA(); const unsigned* LTOK = WSP(unsigned, WS_LTOK);
            moe::Tables T;
            const int total = T.mts[NEXP] * 8;
            LAS unsigned* tokc = (LAS unsigned*)(F.lds + LC_TOKC);
#pragma unroll 1
            for (int i0 = 0; i0 < 20; i0 += 10) { unsigned tk[10];
#pragma unroll
                for (int q = 0; q < 10; ++q) { int mt, pn_; const bool ok = moe::Sched1::map(i0 + q, F.G, F.bid, total, mt, pn_); tk[q] = 0u;
                    if (ok && F.tid < 256) { const int e = moe::find_expert(T, mt); const int pos = mt * 256 + F.tid - T.offs[e]; if (pos < T.cnt[e]) tk[q] = LTOK[(unsigned)(e * LIST_CAP + pos)]; } }
#pragma unroll
                for (int q = 0; q < 10; ++q) if (F.tid < 256) tokc[(i0 + q) * 256 + F.tid] = tk[q] >> 2; }
            __syncthreads();
            moe::Sched1 S{T, (const char*)WSP(unsigned char, WS_X1F8), (const char*)(WSP(unsigned char, WS_WGU) + (size_t)layer * NEXP * 2048 * DM), tokc, F.G, F.bid, total};
            moe::EpiAct E{WSP(unsigned char, WS_ACT), KIN(19) + (size_t)layer * NEXP * 2048};
            pg8::gemm_phase<moe::EpiAct, moe::Sched1, true, true>(F.lds + RING_OFF, DM / 2, S, E, F.tid);
        PHASE_REDO(pb + 5); }
        SEAM(pb + 5);
        if (PON(7) && IN(pb + 6)) PHASE_LOOP(pb + 6) { REFRAME();
            if (MK_N_LAUNCHES != 1) moe_tables(F, gcnt);
            moe::Tables T;
            KAP ka = KA();
            moe::Sched2 S{T, (const char*)WSP(unsigned char, WS_ACT), (const char*)(WSP(unsigned char, WS_WDN) + (size_t)layer * NEXP * DM * DM), F.G >> 2, (F.G >> 5) * (F.bid & 7) + (F.bid >> 5), T.mts[NEXP], (F.bid >> 3) & 3};
            moe::EpiY E{WSP(unsigned char, WS_Y), KIN(21) + (size_t)layer * NEXP * DM, WSP(float, WS_LGATE), T};
            pg8::gemm_phase<moe::EpiY, moe::Sched2, true, true>(F.lds + RING_OFF, DM / 2, S, E, F.tid);
        PHASE_REDO(pb + 6); }
        if (PON(8) && IN(pb + 7)) PHASE_LOOP(pb + 7) { REFRAME();
            KAP ka = KA(); pg8::DenseSchedF8 S; S.init(WSP(unsigned char, WS_X1F8), WSP(unsigned char, WS_WPG8) + (size_t)layer * DM * DM, NTOK, DM, DM / 2, F.G, F.bid);
            pg8::EpiPle E{WSP(bf16_t, WS_X1B), WSP(bf16_t, WS_PRE), WSP(bf16_t, WS_TPP)};
            pg8::gemm_phase<pg8::EpiPle, pg8::DenseSchedF8, true, true>(F.lds + RING_OFF, DM / 2, S, E, F.tid);
        PHASE_REDO(pb + 7); }
        SEAM(pb + 7);
        if (PON(9) && IN(pb + 8)) PHASE_LOOP(pb + 8) { REFRAME();
            if (MK_N_LAUNCHES != 1) moe_tables(F, gcnt);
            KAP ka = KA();
            phase_combine_ln(F, WSP(bf16_t, WS_PRE), WSP(unsigned char, WS_Y), WSP(int, WS_TOKE), WSP(int, WS_TOKP), KIN(24) + layer * DM, KIN(25) + layer * DM, (layer + 1 == DEPTH) ? ka->out : (float*)nullptr, WSP(bf16_t, WS_XB), WSP(unsigned char, WS_XB8));
            VM_WAIT(); __syncthreads(); PHASE_REDO(pb + 8);
        }
        if (layer + 1 < DEPTH) SEAM(pb + 8);
    }

#undef IN
#undef SEAM
}

extern "C" void kernel_launch(void* const* d_in, const int* in_sizes, int n_in, void* d_out, int out_size, void* d_ws, size_t ws_size, hipStream_t stream) {
    static int grid = 0;
    if (grid == 0) {
        if (n_in != 26 || out_size != NTOK * DM || ws_size < WS_END) { fprintf(stderr, "kernel_launch: unexpected shapes (n_in %d, out %d, ws %zu)\n", n_in, out_size, ws_size); grid = -1; return; }
        int dev = 0, cus = 0, per_cu = 0;
        if (hipGetDevice(&dev) != hipSuccess || hipDeviceGetAttribute(&cus, hipDeviceAttributeMultiprocessorCount, dev) != hipSuccess) { grid = -1; return; }
        if (hipFuncSetAttribute((const void*)mk_fwd, hipFuncAttributeMaxDynamicSharedMemorySize, LDS_BYTES) != hipSuccess) { fprintf(stderr, "kernel_launch: hipFuncSetAttribute failed\n"); grid = -1; return; }
        if (hipOccupancyMaxActiveBlocksPerMultiprocessor(&per_cu, (const void*)mk_fwd, NWAVES * 64, LDS_BYTES) != hipSuccess || per_cu < 1) { fprintf(stderr, "kernel_launch: occupancy query says %d\n", per_cu); }
        (void)hipGetLastError();
        grid = cus - cus % 32;
    }
    if (grid < 0) return;
    if (hipMemsetAsync((char*)d_ws + WS_CTL, 0, CTL_ZERO_BYTES, stream) != hipSuccess) return;
    KArgs a{};
    for (int i = 0; i < 26; ++i) a.in[i] = (const float*)d_in[i];
    a.out = (float*)d_out; a.ws = (unsigned char*)d_ws;
    if (MK_N_LAUNCHES == 1) {
        a.ph_lo = 0; a.ph_hi = NPHASES;
        hipLaunchKernelGGL(mk_fwd, dim3(grid), dim3(NWAVES * 64), LDS_BYTES, stream, a);
    } else {
        for (int ph = 0; ph < NPHASES; ++ph) { a.ph_lo = ph; a.ph_hi = ph + 1; hipLaunchKernelGGL(mk_fwd, dim3(grid), dim3(NWAVES * 64), LDS_BYTES, stream, a); }
    }
}
```
